# Optimizing an MI355X kernel written in HIP

```python
import jax, jax.numpy as jnp
from jax import lax
import numpy as np

D_MODEL = 1024
BATCH = 8
SEQ = 4096
DEPTH = 2

D_MIX = D_MODEL
MLA_HEADS = 6
MLA_NOPE = 64
MLA_ROPE = 32
MLA_V = 64
Q_RANK = 256
KV_RANK = 128
MLA_WIDTH = MLA_HEADS * MLA_V
FOX_HEADS = 6
FOX_DIM = 64
FOX_WIDTH = FOX_HEADS * FOX_DIM
CONV_WIDTH = D_MIX - MLA_WIDTH - FOX_WIDTH
CONV_K = 3
D_FF = 2816
PLE_DIM = 256
BLOCK = 128
ROPE_THETA = 10000.0
EPS = 1e-6

IN_SIZES = (Q_RANK, KV_RANK, MLA_ROPE,
            CONV_WIDTH, CONV_WIDTH, CONV_WIDTH,
            FOX_WIDTH, FOX_WIDTH, FOX_WIDTH, FOX_HEADS)
N_IN = sum(IN_SIZES)
IN_SPLITS = [sum(IN_SIZES[:j + 1]) for j in range(len(IN_SIZES) - 1)]

kernel_name = "hymba_style_mla_shortconv_fox_hybrid"


def rmsnorm(x, g):
    xf = x.astype(jnp.float32)
    y = xf * lax.rsqrt(jnp.mean(xf * xf, axis=-1, keepdims=True) + EPS)
    return (y * g.astype(jnp.float32)).astype(x.dtype)


def rope_tables(positions):
    inv_freq = ROPE_THETA ** (-jnp.arange(0, MLA_ROPE, 2, dtype=jnp.float32) / MLA_ROPE)
    ang = positions.astype(jnp.float32)[..., None] * inv_freq
    return jnp.cos(ang), jnp.sin(ang)


def apply_rope(x, cos, sin):
    xf = x.astype(jnp.float32)
    x1, x2 = jnp.split(xf, 2, axis=-1)
    out = jnp.concatenate([x1 * cos - x2 * sin, x1 * sin + x2 * cos], axis=-1)
    return out.astype(x.dtype)


def causal_dwconv(x, w, b=None):
    s = x.shape[1]
    xp = jnp.pad(x, ((0, 0), (CONV_K - 1, 0), (0, 0)))
    y = xp[:, 0:s] * w[0]
    for j in range(1, CONV_K):
        y = y + xp[:, j:j + s] * w[j]
    if b is not None:
        y = y + b
    return y


def blocked_causal_attention(q, k, v, log_decay_cum=None):
    b, s, h, dk = q.shape
    nb = s // BLOCK
    scale = dk ** -0.5
    q_blocks = q.reshape(b, nb, BLOCK, h, dk).swapaxes(0, 1)
    starts = jnp.arange(nb, dtype=jnp.int32) * BLOCK
    k_pos = jnp.arange(s, dtype=jnp.int32)
    if log_decay_cum is None:
        xs = (q_blocks, starts)
    else:
        c_blocks = log_decay_cum.reshape(b, h, nb, BLOCK).transpose(2, 0, 1, 3)
        xs = (q_blocks, starts, c_blocks)

    def attend(blk):
        qi, start = blk[0], blk[1]
        sc = jnp.einsum('bqhd,bkhd->bhqk', qi, k).astype(jnp.float32) * scale
        if log_decay_cum is not None:
            sc = sc + blk[2][..., :, None] - log_decay_cum[:, :, None, :]
        q_pos = start + jnp.arange(BLOCK, dtype=jnp.int32)
        mask = k_pos[None, :] <= q_pos[:, None]
        sc = jnp.where(mask, sc, -jnp.inf)
        pr = jax.nn.softmax(sc, axis=-1).astype(v.dtype)
        return jnp.einsum('bhqk,bkhd->bqhd', pr, v)

    o = lax.map(attend, xs)
    return o.swapaxes(0, 1).reshape(b, s, h, v.shape[-1])


def mla_mixer(zq, zkv, zr, cos, sin, q_norm, w_uq, kv_norm, w_ukv):
    b, s, _ = zq.shape
    q = (rmsnorm(zq, q_norm) @ w_uq).reshape(b, s, MLA_HEADS, MLA_NOPE + MLA_ROPE)
    q_nope, q_rope = q[..., :MLA_NOPE], q[..., MLA_NOPE:]
    q_rope = apply_rope(q_rope, cos[:, :, None, :], sin[:, :, None, :])
    kv = (rmsnorm(zkv, kv_norm) @ w_ukv).reshape(b, s, MLA_HEADS, MLA_NOPE + MLA_V)
    k_nope, v = kv[..., :MLA_NOPE], kv[..., MLA_NOPE:]
    k_rope = apply_rope(zr, cos, sin)
    k = jnp.concatenate([k_nope, jnp.broadcast_to(k_rope[:, :, None, :], (b, s, MLA_HEADS, MLA_ROPE))], axis=-1)
    q = jnp.concatenate([q_nope, q_rope], axis=-1)
    return blocked_causal_attention(q, k, v).reshape(b, s, MLA_WIDTH)


def conv_mixer(zb, zc, zh, conv_w):
    return zb * causal_dwconv(zc * zh, conv_w)


def fox_mixer(fq, fk, fv, ff, b_forget):
    b, s, _ = fq.shape
    q = fq.reshape(b, s, FOX_HEADS, FOX_DIM)
    k = fk.reshape(b, s, FOX_HEADS, FOX_DIM)
    v = fv.reshape(b, s, FOX_HEADS, FOX_DIM)
    log_f = jax.nn.log_sigmoid(ff.astype(jnp.float32) + b_forget.astype(jnp.float32))
    cum = jnp.cumsum(log_f, axis=1).transpose(0, 2, 1)
    return blocked_causal_attention(q, k, v, cum).reshape(b, s, FOX_WIDTH)


def conv_glu_ffn(m, w_up, conv_w, conv_b, w_down):
    u = causal_dwconv(m @ w_up, conv_w, conv_b)
    g, val = jnp.split(u, 2, axis=-1)
    return (jax.nn.silu(g) * val) @ w_down


def setup_inputs(seed: int = 0) -> dict:
    key = jax.random.key(seed)
    ks = jax.random.split(key, 24)
    f32 = jnp.float32

    def nrm(k, shape, fan_in):
        return jax.random.normal(k, shape, f32) * (fan_in ** -0.5)

    def gain(k, shape):
        return 1.0 + 0.05 * jax.random.normal(k, shape, f32)

    x = jax.random.normal(ks[0], (BATCH, SEQ, D_MODEL), f32)
    p = jax.random.normal(ks[1], (DEPTH, BATCH, SEQ, PLE_DIM), f32)
    offsets = jax.random.randint(ks[2], (BATCH, 1), 0, 1024, dtype=jnp.int32)
    positions = offsets + jnp.arange(SEQ, dtype=jnp.int32)[None, :]
    return {
        "x": x,
        "p": p,
        "positions": positions,
        "attn_norm": gain(ks[3], (DEPTH, D_MODEL)),
        "w_in": nrm(ks[4], (DEPTH, D_MODEL, N_IN), D_MODEL),
        "b_forget": 2.0 + 0.1 * jax.random.normal(ks[5], (DEPTH, FOX_HEADS), f32),
        "q_norm": gain(ks[6], (DEPTH, Q_RANK)),
        "w_uq": nrm(ks[7], (DEPTH, Q_RANK, MLA_HEADS * (MLA_NOPE + MLA_ROPE)), Q_RANK),
        "kv_norm": gain(ks[8], (DEPTH, KV_RANK)),
        "w_ukv": nrm(ks[9], (DEPTH, KV_RANK, MLA_HEADS * (MLA_NOPE + MLA_V)), KV_RANK),
        "conv_w": nrm(ks[10], (DEPTH, CONV_K, CONV_WIDTH), CONV_K),
        "mla_out_norm": gain(ks[11], (DEPTH, MLA_WIDTH)),
        "conv_out_norm": gain(ks[12], (DEPTH, CONV_WIDTH)),
        "fox_out_norm": gain(ks[13], (DEPTH, FOX_WIDTH)),
        "w_out": nrm(ks[14], (DEPTH, D_MIX, D_MODEL), D_MIX),
        "ffn_norm": gain(ks[15], (DEPTH, D_MODEL)),
        "w_up": nrm(ks[16], (DEPTH, D_MODEL, 2 * D_FF), D_MODEL),
        "ffn_conv_w": nrm(ks[17], (DEPTH, CONV_K, 2 * D_FF), CONV_K),
        "ffn_conv_b": 0.02 * jax.random.normal(ks[18], (DEPTH, 2 * D_FF), f32),
        "w_down": nrm(ks[19], (DEPTH, D_FF, D_MODEL), D_FF),
        "ple_norm": gain(ks[20], (DEPTH, D_MODEL)),
        "w_ple_gate": nrm(ks[21], (DEPTH, D_MODEL, D_MODEL), D_MODEL),
        "w_ple": nrm(ks[22], (DEPTH, PLE_DIM, D_MODEL), PLE_DIM),
        "final_norm": gain(ks[23], (D_MODEL,)),
    }


def reference(x, p, positions, attn_norm, w_in, b_forget, q_norm, w_uq, kv_norm, w_ukv,
              conv_w, mla_out_norm, conv_out_norm, fox_out_norm, w_out, ffn_norm, w_up,
              ffn_conv_w, ffn_conv_b, w_down, ple_norm, w_ple_gate, w_ple, final_norm):
    cos, sin = rope_tables(positions)
    h = x
    for i in range(DEPTH):
        a = rmsnorm(h, attn_norm[i])
        z = a @ w_in[i]
        zq, zkv, zr, zb, zc, zh, fq, fk, fv, ff = jnp.split(z, IN_SPLITS, axis=-1)
        o_mla = mla_mixer(zq, zkv, zr, cos, sin, q_norm[i], w_uq[i], kv_norm[i], w_ukv[i])
        o_conv = conv_mixer(zb, zc, zh, conv_w[i])
        o_fox = fox_mixer(fq, fk, fv, ff, b_forget[i])
        mixed = jnp.concatenate([rmsnorm(o_mla, mla_out_norm[i]),
                                 rmsnorm(o_conv, conv_out_norm[i]),
                                 rmsnorm(o_fox, fox_out_norm[i])], axis=-1)
        h = h + mixed @ w_out[i]
        m = rmsnorm(h, ffn_norm[i])
        h = h + conv_glu_ffn(m, w_up[i], ffn_conv_w[i], ffn_conv_b[i], w_down[i])
        gate = jax.nn.sigmoid(rmsnorm(h, ple_norm[i]) @ w_ple_gate[i])
        h = h + gate * (p[i] @ w_ple[i])
    return rmsnorm(h, final_norm)
```

```cpp
#include <hip/hip_runtime.h>
#include <hip/hip_cooperative_groups.h>
#include <cstdio>
#include <cstdint>
#include <cmath>
namespace cg = cooperative_groups;

#define LAS __attribute__((address_space(3)))
typedef unsigned short bf16_t;
typedef short bf16x8 __attribute__((ext_vector_type(8)));
typedef short s16x4 __attribute__((ext_vector_type(4)));
typedef float f32x4 __attribute__((ext_vector_type(4)));
typedef float f32x2 __attribute__((ext_vector_type(2)));
typedef float f32x16 __attribute__((ext_vector_type(16)));
typedef unsigned u32x4 __attribute__((ext_vector_type(4)));
typedef unsigned u32x2 __attribute__((ext_vector_type(2)));

#define GAS __attribute__((address_space(1)))
template <class T> __device__ __forceinline__ T gld(const void* base, unsigned byteoff) { return *(const GAS T*)((const GAS char*)base + byteoff); }
template <class T> __device__ __forceinline__ void gst(void* base, unsigned byteoff, T v) { *(GAS T*)((GAS char*)base + byteoff) = v; }
template <class T> __device__ __forceinline__ void gst_nt(void* base, unsigned byteoff, T v) { __builtin_nontemporal_store(v, (GAS T*)((GAS char*)base + byteoff)); }
__device__ __forceinline__ void gatomic_add(float* base, unsigned byteoff, float v) { (void)__hip_atomic_fetch_add((GAS float*)((GAS char*)base + byteoff), v, __ATOMIC_RELAXED, __HIP_MEMORY_SCOPE_AGENT); }

__device__ __forceinline__ float ss_sum(const float* ss, unsigned row, int nslots) {
    if (nslots == 1) return gld<float>(ss, row * 64u);
    f32x4 a = gld<f32x4>(ss, row * 64u);
    if (nslots == 16) { const f32x4 b = gld<f32x4>(ss, row * 64u + 16), c = gld<f32x4>(ss, row * 64u + 32), d = gld<f32x4>(ss, row * 64u + 48); a = (a + b) + (c + d); }
    return (a[0] + a[1]) + (a[2] + a[3]);
}
constexpr int DM = 1024, NBATCH = 8, SEQ = 4096, MROWS = NBATCH * SEQ, DEPTH = 2;
constexpr int NIN_SRC = 2342, NIN = 2560;
constexpr int QW = 576, KVW = 768, DFF = 2816, NUP = 5632, PLE = 256;
constexpr float EPS = 1e-6f;
constexpr float LOG2E = 1.4426950408889634f;
constexpr float C2_MLA = 0.10206207261596577f * LOG2E;
constexpr float C2_FOX = 0.125f * LOG2E;
constexpr int ZC_ZB = 512, ZC_ZC = 768, ZC_ZH = 1024, ZC_FQ = 1280, ZC_FK = 1664, ZC_FV = 2048;

__device__ __forceinline__ unsigned f2bf(float f) { unsigned u = __builtin_bit_cast(unsigned, f); return (u + 0x7fffu + ((u >> 16) & 1u)) >> 16; }
__device__ __forceinline__ unsigned pk2(float lo, float hi) { typedef __bf16 bf2 __attribute__((ext_vector_type(2))); f32x2 v = {lo, hi}; bf2 b = __builtin_convertvector(v, bf2); return __builtin_bit_cast(unsigned, b); }
__device__ __forceinline__ float bflo(unsigned u) { return __builtin_bit_cast(float, u << 16); }
__device__ __forceinline__ float bfhi(unsigned u) { return __builtin_bit_cast(float, u & 0xffff0000u); }
__device__ __forceinline__ float wave_sum(float v) {
#pragma unroll
    for (int o = 1; o < 64; o <<= 1) v += __shfl_xor(v, o);
    return v;
}
__device__ __forceinline__ float sigmoidf_(float x) { return __builtin_amdgcn_rcpf(1.f + __expf(-x)); }

namespace pg8 {
constexpr int BM = 256, BK = 64, HALF = 128, HTB = HALF * BK * 2  , STAGE_BYTES = 8 * HTB, NXCD = 8, WGM = 4;

__host__ __device__ __forceinline__ int lds_byte(int r, int c) { const int st = (r >> 4) * 2 + (c >> 5), rr = r & 15, cc = c & 31, ob = rr * 64 + cc * 2; return st * 1024 + (ob ^ (((ob >> 9) & 1) << 5)); }
__host__ __device__ __forceinline__ void stage_rc(int b, int& R, int& C) { const int st = b / 1024, sb = b % 1024, swz = sb ^ (((sb >> 9) & 1) << 5); R = (st >> 1) * 16 + swz / 64; C = (st & 1) * 32 + (swz % 64) / 2; }
__host__ __device__ __forceinline__ int perm32(int rho) { const int n = rho >> 4, i = rho & 15; return 8 * (i >> 2) + 4 * n + (i & 3); }

struct Unit { int pm, pn; };
struct Gemm { const bf16_t* A; const bf16_t* Bt; int M, N, K, lda, ldb, rstep, roff; };

struct StaticOrder {
    int nM, nN, nwg, G, c;
    __host__ __device__ void init(int M, int N, int G_, int c_) { nM = M / BM; nN = N / BM; nwg = nM * nN; G = G_; c = c_; }
    __host__ __device__ bool next(int i, Unit& u) const {
        const long L = (long)i * G + c; if (L >= nwg) return false;
        int wgid = (int)L; { const int q = nwg / NXCD, r = nwg % NXCD, xcd = wgid % NXCD, off = wgid / NXCD; wgid = (xcd < r ? xcd * (q + 1) : r * (q + 1) + (xcd - r) * q) + off; }
        const int nig = WGM * nN, gid = wgid / nig, fm = gid * WGM, gsz = (nM - fm) < WGM ? (nM - fm) : WGM;
        u.pm = fm + ((wgid % nig) % gsz); u.pn = (wgid % nig) / gsz; return true;
    }
};

__device__ __forceinline__ u32x4 pack8(const f32x4 v0, const f32x4 v1) { u32x4 w; w.x = pk2(v0[0], v0[1]); w.y = pk2(v0[2], v0[3]); w.z = pk2(v1[0], v1[1]); w.w = pk2(v1[2], v1[3]); return w; }
__device__ __forceinline__ float dot8(const f32x4 v0, const f32x4 v1) { return (v0[0] * v0[0] + v0[1] * v0[1]) + (v0[2] * v0[2] + v0[3] * v0[3]) + (v1[0] * v1[0] + v1[1] * v1[1]) + (v1[2] * v1[2] + v1[3] * v1[3]); }
__device__ __forceinline__ void rope8(f32x4& v0, f32x4& v1, const float* cs, unsigned row, int fq) {
    const f32x4 c0 = gld<f32x4>(cs, (row * 32 + 8 * fq) * 4), c1 = gld<f32x4>(cs, (row * 32 + 8 * fq + 4) * 4);
    f32x4 a, b;
    a[0] = v0[0] * c0[0] - v0[1] * c0[1]; a[1] = v0[0] * c0[1] + v0[1] * c0[0];
    a[2] = v0[2] * c0[2] - v0[3] * c0[3]; a[3] = v0[2] * c0[3] + v0[3] * c0[2];
    b[0] = v1[0] * c1[0] - v1[1] * c1[1]; b[1] = v1[0] * c1[1] + v1[1] * c1[0];
    b[2] = v1[2] * c1[2] - v1[3] * c1[3]; b[3] = v1[2] * c1[3] + v1[3] * c1[2];
    v0 = a; v1 = b;
}

struct EpiRowScale {
    static constexpr bool PERM = true, INIT_ACC = false;
    bf16_t* O; int ldc; const float* ss; int nslots; float inv_n, mul;
    __device__ __forceinline__ void operator()(f32x4 (&acc)[2][2][4][2], const Unit& u, int wr, int wc, int fr, int fq, LAS unsigned char* xl) const {
        const int row0 = u.pm * BM + wr * 64 + fr, col0 = u.pn * BM + wc * 32 + 8 * fq;
#pragma unroll
        for (int ai = 0; ai < 2; ++ai)
#pragma unroll
            for (int m = 0; m < 4; ++m) { const int row = row0 + ai * HALF + m * 16;
                const float sc = ss ? __builtin_amdgcn_rsqf(ss_sum(ss, (unsigned)row, nslots) * inv_n + EPS) * mul : mul;
                const unsigned ob = ((unsigned)row * (unsigned)ldc + (unsigned)col0) * 2u;
#pragma unroll
                for (int bj = 0; bj < 2; ++bj) gst<u32x4>(O, ob + bj * HALF * 2, pack8(acc[ai][bj][m][0] * sc, acc[ai][bj][m][1] * sc));
                if (m == 3) asm volatile("" ::: "memory");     }
    }
};

struct EpiZ {
    static constexpr bool PERM = true, INIT_ACC = false;
    bf16_t* z; const float* ss_in; int nslots; float* ss_q; float* ss_kv; float* ffbuf; bf16_t* krope; const float* cs; unsigned* nb;
    __device__ __forceinline__ void operator()(f32x4 (&acc)[2][2][4][2], const Unit& u, int wr, int wc, int fr, int fq, LAS unsigned char* xl) const {
        const int row0 = u.pm * BM + wr * 64 + fr, col0 = u.pn * BM + wc * 32 + 8 * fq; const int pn = u.pn;
        const bool fox_qk = pn >= 5 && pn <= 7;
        float nbm[2] = {0.f, 0.f};
#pragma unroll
        for (int ai = 0; ai < 2; ++ai)
#pragma unroll
            for (int m = 0; m < 4; ++m) { const int row = row0 + ai * HALF + m * 16;
                const float rs = __builtin_amdgcn_rsqf(ss_sum(ss_in, (unsigned)row, nslots) * (1.f / DM) + EPS);
                const unsigned ob = ((unsigned)row * NIN + (unsigned)col0) * 2u; float sq = 0.f;
#pragma unroll
                for (int bj = 0; bj < 2; ++bj) { f32x4 v0 = acc[ai][bj][m][0] * rs, v1 = acc[ai][bj][m][1] * rs;
                    if (pn == 0 || (pn == 1 && bj == 0)) sq += dot8(v0, v1);
                    if (pn == 1 && bj == 1) {
                        if (wc == 0) { rope8(v0, v1, cs, (unsigned)row, fq); gst<u32x4>(krope, ((unsigned)row * 32 + 8 * fq) * 2, pack8(v0, v1)); }
                        if (wc == 1 && fq == 0) { gst<f32x4>(ffbuf, (unsigned)row * 32, v0); gst<f32x4>(ffbuf, (unsigned)row * 32 + 16, v1); }
                    }
                    if (pn == 5 || (pn == 6 && bj == 0)) { v0 = v0 * C2_FOX; v1 = v1 * C2_FOX; }
                    if (fox_qk) { float s = dot8(v0, v1); s += __shfl_xor(s, 16); s += __shfl_xor(s, 32); nbm[bj] = fmaxf(nbm[bj], s); }
                    gst<u32x4>(z, ob + bj * HALF * 2, pack8(v0, v1)); }
                if (pn <= 1) { sq += __shfl_xor(sq, 16); sq += __shfl_xor(sq, 32); if (fq == 0) gst<float>(pn == 0 ? ss_q : ss_kv, ((unsigned)row * 16u + wc) * 4u, sq); }
                if (m == 3) asm volatile("" ::: "memory");
            }
        if (fox_qk) {
#pragma unroll
            for (int bj = 0; bj < 2; ++bj) { float v = nbm[bj];
#pragma unroll
                for (int o = 1; o < 16; o <<= 1) v = fmaxf(v, __shfl_xor(v, o));
                const int g32 = pn * 8 + bj * 4 + wc, isk = g32 >= 52 ? 1 : 0, gl = g32 - (isk ? 52 : 40), bh = (u.pm * BM / SEQ) * 6 + (gl >> 1);
                if (fr == 0 && fq == 0) atomicMax(nb + bh + 128 * isk + 256 * (gl & 1), __float_as_uint(v)); }
        }
    }
};

struct EpiQ {
    static constexpr bool PERM = true, INIT_ACC = false;
    bf16_t* q; const float* ss; const float* cs;
    __device__ __forceinline__ void operator()(f32x4 (&acc)[2][2][4][2], const Unit& u, int wr, int wc, int fr, int fq, LAS unsigned char* xl) const {
        const int row0 = u.pm * BM + wr * 64 + fr;
#pragma unroll
        for (int ai = 0; ai < 2; ++ai)
#pragma unroll
            for (int m = 0; m < 4; ++m) { const int row = row0 + ai * HALF + m * 16;
                const float rs = __builtin_amdgcn_rsqf(ss_sum(ss, (unsigned)row, 4) * (1.f / 256.f) + EPS) * C2_MLA;
#pragma unroll
                for (int bj = 0; bj < 2; ++bj) { const int g = u.pn * BM + bj * HALF + wc * 32;
                    if (g < QW) { f32x4 v0 = acc[ai][bj][m][0] * rs, v1 = acc[ai][bj][m][1] * rs;
                        if (((g >> 5) % 3) == 2) rope8(v0, v1, cs, (unsigned)row, fq);
                        gst<u32x4>(q, ((unsigned)row * QW + g + 8 * fq) * 2, pack8(v0, v1)); } }
                if (m == 3) asm volatile("" ::: "memory");
            }
    }
};

__device__ __forceinline__ void unpack8(const u32x4 w, f32x4& a, f32x4& b) { a[0] = bflo(w.x); a[1] = bfhi(w.x); a[2] = bflo(w.y); a[3] = bfhi(w.y); b[0] = bflo(w.z); b[1] = bfhi(w.z); b[2] = bflo(w.w); b[3] = bfhi(w.w); }
struct EpiRes {
    static constexpr bool PERM = true, INIT_ACC = true;
    const bf16_t* hin; bf16_t* hb; float* ss_out;
    __device__ __forceinline__ void init_acc(f32x4 (&acc)[2][2][4][2], const Unit& u, int wr, int wc, int fr, int fq) const {
        const int row0 = u.pm * BM + wr * 64 + fr, col0 = u.pn * BM + wc * 32 + 8 * fq;
#pragma unroll
        for (int ai = 0; ai < 2; ++ai)
#pragma unroll
            for (int m = 0; m < 4; ++m) { const unsigned off = ((unsigned)(row0 + ai * HALF + m * 16) * DM + (unsigned)col0) * 2u;
#pragma unroll
                for (int bj = 0; bj < 2; ++bj) unpack8(gld<u32x4>(hin, off + bj * HALF * 2), acc[ai][bj][m][0], acc[ai][bj][m][1]); }
    }
    __device__ __forceinline__ void operator()(f32x4 (&acc)[2][2][4][2], const Unit& u, int wr, int wc, int fr, int fq, LAS unsigned char* xl) const {
        const int row0 = u.pm * BM + wr * 64 + fr, col0 = u.pn * BM + wc * 32 + 8 * fq;
#pragma unroll
        for (int ai = 0; ai < 2; ++ai)
#pragma unroll
            for (int m = 0; m < 4; ++m) { const int row = row0 + ai * HALF + m * 16; const unsigned off = ((unsigned)row * DM + (unsigned)col0) * 2u; float sq = 0.f;
#pragma unroll
                for (int bj = 0; bj < 2; ++bj) { const f32x4 v0 = acc[ai][bj][m][0], v1 = acc[ai][bj][m][1];
                    gst<u32x4>(hb, off + bj * HALF * 2, pack8(v0, v1)); sq += dot8(v0, v1); }
                sq += __shfl_xor(sq, 16); sq += __shfl_xor(sq, 32); if (fq == 0) gst<float>(ss_out, ((unsigned)row * 16u + u.pn * 4 + wc) * 4u, sq);
                if (m == 3) asm volatile("" ::: "memory");
            }
    }
};

struct EpiGate {
    static constexpr bool PERM = true, INIT_ACC = false;
    const bf16_t* hin; bf16_t* hb; float* ss_out; const float* ss_in; const bf16_t* t;
    __device__ __forceinline__ void operator()(f32x4 (&acc)[2][2][4][2], const Unit& u, int wr, int wc, int fr, int fq, LAS unsigned char* xl) const {
        const int row0 = u.pm * BM + wr * 64 + fr, col0 = u.pn * BM + wc * 32 + 8 * fq;
#pragma unroll
        for (int ai = 0; ai < 2; ++ai)
#pragma unroll
            for (int m = 0; m < 4; ++m) { const int row = row0 + ai * HALF + m * 16; const unsigned off = ((unsigned)row * DM + (unsigned)col0) * 2u; float sq = 0.f;
                const float rs = __builtin_amdgcn_rsqf(ss_sum(ss_in, (unsigned)row, 16) * (1.f / DM) + EPS);
#pragma unroll
                for (int bj = 0; bj < 2; ++bj) { f32x4 h0, h1, t0, t1; unpack8(gld<u32x4>(hin, off + bj * HALF * 2), h0, h1); unpack8(gld<u32x4>(t, off + bj * HALF * 2), t0, t1);
                    const f32x4 a0 = acc[ai][bj][m][0] * rs, a1 = acc[ai][bj][m][1] * rs;
                    f32x4 v0, v1;
#pragma unroll
                    for (int e = 0; e < 4; ++e) { v0[e] = h0[e] + sigmoidf_(a0[e]) * t0[e]; v1[e] = h1[e] + sigmoidf_(a1[e]) * t1[e]; }
                    gst<u32x4>(hb, off + bj * HALF * 2, pack8(v0, v1)); sq += dot8(v0, v1); }
                sq += __shfl_xor(sq, 16); sq += __shfl_xor(sq, 32); if (fq == 0) gst<float>(ss_out, ((unsigned)row * 16u + u.pn * 4 + wc) * 4u, sq);
                if (m == 3) asm volatile("" ::: "memory");
            }
    }
};

__device__ __forceinline__ float dpp_shr1(float old, float src) { return __int_as_float(__builtin_amdgcn_update_dpp(__float_as_int(old), __float_as_int(src), 0x111, 0xf, 0xf, false)); }
__device__ __forceinline__ float dpp_shr2(float old, float src) { return __int_as_float(__builtin_amdgcn_update_dpp(__float_as_int(old), __float_as_int(src), 0x112, 0xf, 0xf, false)); }
__device__ __forceinline__ float dpp_ror1(float src) { return __int_as_float(__builtin_amdgcn_mov_dpp(__float_as_int(src), 0x121, 0xf, 0xf, true)); }
__device__ __forceinline__ float dpp_ror2(float src) { return __int_as_float(__builtin_amdgcn_mov_dpp(__float_as_int(src), 0x122, 0xf, 0xf, true)); }
struct EpiFfn {
    static constexpr bool PERM = true, INIT_ACC = false;
    bf16_t* act; const float* ss; const float* cw; const float* cb;
    __device__ __forceinline__ void operator()(f32x4 (&acc)[2][2][4][2], const Unit& u, int wr, int wc, int fr, int fq, LAS unsigned char* xl) const {
        LAS unsigned char* Bb = xl;
        const int rbase = u.pm * 254 - 2;
        float rs8[2][4];
#pragma unroll
        for (int ai = 0; ai < 2; ++ai) {
#pragma unroll
            for (int m = 0; m < 4; ++m) { const int rg = rbase + ai * HALF + wr * 64 + m * 16 + fr; const int rgc = rg < 0 ? 0 : (rg >= MROWS ? MROWS - 1 : rg);
                rs8[ai][m] = __builtin_amdgcn_rsqf(ss_sum(ss, (unsigned)rgc, 16) * (1.f / DM) + EPS); }
            asm volatile("" : "+v"(rs8[ai][0]), "+v"(rs8[ai][1]), "+v"(rs8[ai][2]), "+v"(rs8[ai][3]) :: "memory"); }
#pragma unroll
        for (int ai = 0; ai < 2; ++ai)
#pragma unroll
            for (int m = 0; m < 4; ++m) {
#pragma unroll
                for (int bj = 0; bj < 2; ++bj) { acc[ai][bj][m][0] = acc[ai][bj][m][0] * rs8[ai][m]; acc[ai][bj][m][1] = acc[ai][bj][m][1] * rs8[ai][m]; }
                asm volatile("" : "+v"(acc[ai][0][m][0]), "+v"(acc[ai][0][m][1]), "+v"(acc[ai][1][m][0]), "+v"(acc[ai][1][m][1])); }
        if (fr >= 14) {
#pragma unroll
            for (int ai = 0; ai < 2; ++ai)
#pragma unroll
                for (int bj = 0; bj < 2; ++bj) { LAS unsigned char* p = Bb + ((ai * 2 + wr) * 2 + (fr - 14)) * 1024 + (bj * 128 + wc * 32 + fq * 8) * 4;
                    *(LAS f32x4*)p = acc[ai][bj][3][0]; *(LAS f32x4*)(p + 16) = acc[ai][bj][3][1]; }
        }
        asm volatile("s_waitcnt lgkmcnt(0)" ::: "memory"); __builtin_amdgcn_s_barrier(); asm volatile("" ::: "memory");
#pragma unroll
        for (int bj = 0; bj < 2; ++bj) {
            const int ch = bj * DFF + 128 * u.pn + 32 * wc + 8 * fq;
            f32x4 w0[2], w1[2], w2[2], bb[2];
#pragma unroll
            for (int n = 0; n < 2; ++n) { w0[n] = gld<f32x4>(cw, (ch + 4 * n) * 4); w1[n] = gld<f32x4>(cw, (NUP + ch + 4 * n) * 4); w2[n] = gld<f32x4>(cw, (2 * NUP + ch + 4 * n) * 4); bb[n] = gld<f32x4>(cb, (ch + 4 * n) * 4); }
#pragma unroll
            for (int ai = 0; ai < 2; ++ai) {
                f32x4 pg[2];
                pg[0] = (f32x4){0.f, 0.f, 0.f, 0.f}; pg[1] = pg[0];
#pragma unroll
                for (int m = 0; m < 4; ++m) {
                    f32x4 y[2] = {acc[ai][bj][m][0], acc[ai][bj][m][1]}; asm volatile("" : "+v"(y[0]), "+v"(y[1]));
                    f32x4 x1[2], x2[2];
                    if (m == 0) {
                        x1[0] = pg[0]; x1[1] = pg[0]; x2[0] = pg[0]; x2[1] = pg[0];
                        if (wr == 1 || ai == 1) { const int pai = wr == 1 ? ai : 0, pwr = wr == 1 ? 0 : 1;
                            const LAS unsigned char* p = Bb + ((pai * 2 + pwr) * 2) * 1024 + (bj * 128 + wc * 32 + fq * 8) * 4;
                            if (fr < 2) { x2[0] = *(const LAS f32x4*)(p + fr * 1024); x2[1] = *(const LAS f32x4*)(p + fr * 1024 + 16); }
                            if (fr < 1) { x1[0] = *(const LAS f32x4*)(p + 1024); x1[1] = *(const LAS f32x4*)(p + 1024 + 16); } }
                    } else {
#pragma unroll
                        for (int n = 0; n < 2; ++n)
#pragma unroll
                            for (int e = 0; e < 4; ++e) { x1[n][e] = dpp_ror1(pg[n][e]); x2[n][e] = dpp_ror2(pg[n][e]); }
                    }
                    const int rl = ai * HALF + wr * 64 + m * 16 + fr, rg = rbase + rl; const int tpos = rg & (SEQ - 1);
                    const bool bstart = ((rbase + ai * HALF + wr * 64 + m * 16 + 15) & (SEQ - 1)) < 17;
                    f32x4 o[2], p1[2], p2[2];
#pragma unroll
                    for (int n = 0; n < 2; ++n)
#pragma unroll
                        for (int e = 0; e < 4; ++e) { p1[n][e] = dpp_shr1(x1[n][e], y[n][e]); p2[n][e] = dpp_shr2(x2[n][e], y[n][e]); }
                    if (__builtin_expect(bstart, 0)) {
                        asm volatile("" : "+v"(p1[0]), "+v"(p1[1]), "+v"(p2[0]), "+v"(p2[1]));
                        if (tpos < 1) { p1[0] = (f32x4){0.f, 0.f, 0.f, 0.f}; p1[1] = p1[0]; }
                        if (tpos < 2) { p2[0] = (f32x4){0.f, 0.f, 0.f, 0.f}; p2[1] = p2[0]; } }
#pragma unroll
                    for (int n = 0; n < 2; ++n) o[n] = w0[n] * p2[n] + w1[n] * p1[n] + w2[n] * y[n] + bb[n];
                    pg[0] = y[0]; pg[1] = y[1];
                    if (bj == 0) {
#pragma unroll
                        for (int e = 0; e < 4; ++e) { o[0][e] = o[0][e] * sigmoidf_(o[0][e]); o[1][e] = o[1][e] * sigmoidf_(o[1][e]); }
                        asm volatile("" : "+v"(o[0]), "+v"(o[1]));
                        acc[ai][0][m][0] = o[0]; acc[ai][0][m][1] = o[1];
                    } else {
                        if (rl >= 2 && rg < MROWS) gst<u32x4>(act, ((unsigned)rg * DFF + 128 * u.pn + 32 * wc + 8 * fq) * 2u, pack8(acc[ai][0][m][0] * o[0], acc[ai][0][m][1] * o[1]));
                    }
                    __builtin_amdgcn_sched_barrier(0);
                }
            }
            asm volatile("" ::: "memory");
        }
    }
};

template <class Epi, class Sched, bool ALIGN_EPI>
__device__ __forceinline__ void gemm_phase(LAS unsigned char* lds, LAS unsigned char* xlds, const Gemm g, const Sched& S, const Epi& E) {
    int tid_o = threadIdx.x; asm volatile("" : "+v"(tid_o));
    const int tid = tid_o, wid = __builtin_amdgcn_readfirstlane(tid >> 6), lane = tid & 63, wr = wid >> 2, wc = wid & 3, fr = lane & 15, fq = lane >> 4;
    int K_o = g.K; asm volatile("" : "+s"(K_o));
    const int K = K_o, nt = K / BK;
    unsigned voffA[2], voffB[2];
#pragma unroll
    for (int i = 0; i < 2; ++i) { int R, C; stage_rc(tid * 16 + i * 8192, R, C); const int Rb = Epi::PERM ? ((R & ~31) + perm32(R & 31)) : R;
        voffA[i] = (unsigned)(R * g.lda + C) * 2u; voffB[i] = (unsigned)(Rb * g.ldb + C) * 2u; }
    const size_t kstep = (size_t)(BK * 2);
    const size_t hA = (size_t)HALF * g.lda * 2, hB = (size_t)HALF * g.ldb * 2;
    const size_t tB = 2 * hB; const long rowA = (long)g.lda * 2;
    const unsigned ldsw = (unsigned)wid * 1024u;
    const int aoff = lds_byte(wr * 64 + fr, fq * 8), boff = lds_byte(wc * 32 + fr, fq * 8);
#define PG8_SA(b, h) (((b) * 2 + (h)) * HTB)
#define PG8_SB(b, h) ((4 + (b) * 2 + (h)) * HTB)
#define PG8_STAGE(bufoff, gbase, voff) do { _Pragma("unroll") for (int _i = 0; _i < 2; ++_i) \
        __builtin_amdgcn_global_load_lds((const unsigned*)((const char*)(gbase) + (voff)[_i]), (LAS unsigned*)(lds + (bufoff) + ldsw + _i * 8192), 16, 0, 0); } while (0)
#define PG8_LDA(dst, b, h) do { _Pragma("unroll") for (int m = 0; m < 4; ++m) _Pragma("unroll") for (int k = 0; k < 2; ++k) dst[m][k] = *(const LAS bf16x8*)(lds + PG8_SA(b, h) + aoff + m * 2048 + k * 1024); } while (0)
#define PG8_LDB(dst, b, h) do { _Pragma("unroll") for (int n = 0; n < 2; ++n) _Pragma("unroll") for (int k = 0; k < 2; ++k) dst[n][k] = *(const LAS bf16x8*)(lds + PG8_SB(b, h) + boff + n * 2048 + k * 1024); } while (0)
#define PG8_MMA(ai, bj, At, Bt) do { __builtin_amdgcn_s_setprio(1); _Pragma("unroll") for (int m = 0; m < 4; ++m) _Pragma("unroll") for (int n = 0; n < 2; ++n) _Pragma("unroll") for (int k = 0; k < 2; ++k) \
        acc[ai][bj][m][n] = __builtin_amdgcn_mfma_f32_16x16x32_bf16(Bt[n][k], At[m][k], acc[ai][bj][m][n], 0, 0, 0); __builtin_amdgcn_s_setprio(0); } while (0)
#define PG8_WAIT_V(n) asm volatile("s_waitcnt vmcnt(" #n ")" ::: "memory")
#define PG8_WAIT_L(n) asm volatile("s_waitcnt lgkmcnt(" #n ")" ::: "memory")
#define PG8_BAR __builtin_amdgcn_s_barrier()
#define PG8_SCHED __builtin_amdgcn_sched_barrier(0)
    Unit cur, nxt; int ui = 0;
    if (!S.next(0, cur)) return;
    f32x4 acc[2][2][4][2];
    if constexpr (Epi::INIT_ACC) E.init_acc(acc, cur, wr, wc, fr, fq);
    else {
#pragma unroll
    for (int a = 0; a < 2; ++a)
#pragma unroll
        for (int b = 0; b < 2; ++b)
#pragma unroll
            for (int m = 0; m < 4; ++m)
#pragma unroll
                for (int n = 0; n < 2; ++n) acc[a][b][m][n] = (f32x4){0.f, 0.f, 0.f, 0.f};
    }
    bf16x8 At[4][2], B0[2][2], B1[2][2];
    const char* cA = (const char*)g.A + ((long)cur.pm * g.rstep + g.roff) * rowA; const char* cB = (const char*)g.Bt + (size_t)cur.pn * tB;
    PG8_STAGE(PG8_SB(0, 0), cB, voffB); PG8_STAGE(PG8_SB(0, 1), cB + hB, voffB); PG8_STAGE(PG8_SA(0, 0), cA, voffA); PG8_STAGE(PG8_SA(0, 1), cA + hA, voffA);
    if (wr == 1) PG8_BAR;
    PG8_WAIT_V(2); PG8_BAR;
    PG8_STAGE(PG8_SB(1, 0), cB + kstep, voffB); PG8_STAGE(PG8_SA(1, 0), cA + kstep, voffA); PG8_STAGE(PG8_SB(1, 1), cB + hB + kstep, voffB);
    PG8_WAIT_V(6); PG8_BAR;
    for (;;) {
        const bool has_next = S.next(ui + 1, nxt);
        const char* nA = has_next ? (const char*)g.A + ((long)nxt.pm * g.rstep + g.roff) * rowA : cA; const char* nB = has_next ? (const char*)g.Bt + (size_t)nxt.pn * tB : cB;
        for (int t = 0; t < nt; t += 2) {
            const bool last = (t == nt - 2);
            const char* a1 = cA + (size_t)(t + 1) * kstep;
            const char* a2 = last ? nA : cA + (size_t)(t + 2) * kstep; const char* b2 = last ? nB : cB + (size_t)(t + 2) * kstep;
            const char* a3 = a2 + kstep; const char* b3 = b2 + kstep;
            PG8_LDB(B0, 0, 0); PG8_LDB(B1, 0, 1); PG8_SCHED; PG8_LDA(At, 0, 0); PG8_STAGE(PG8_SA(1, 1), a1 + hA, voffA);
            PG8_WAIT_V(8); PG8_WAIT_L(0); PG8_BAR; PG8_MMA(0, 0, At, B0); PG8_MMA(0, 1, At, B1); PG8_BAR; PG8_SCHED;
            PG8_LDA(At, 0, 1); PG8_STAGE(PG8_SB(0, 0), b2, voffB); PG8_STAGE(PG8_SB(0, 1), b2 + hB, voffB); PG8_STAGE(PG8_SA(0, 0), a2, voffA);
            PG8_WAIT_V(8); PG8_WAIT_L(0); PG8_BAR; PG8_MMA(1, 0, At, B0); PG8_MMA(1, 1, At, B1); PG8_BAR; PG8_SCHED;
            PG8_LDB(B0, 1, 0); PG8_LDB(B1, 1, 1); PG8_SCHED; PG8_LDA(At, 1, 0); PG8_STAGE(PG8_SA(0, 1), a2 + hA, voffA);
            PG8_WAIT_V(8); PG8_WAIT_L(0); PG8_BAR; PG8_MMA(0, 0, At, B0); PG8_MMA(0, 1, At, B1); PG8_BAR; PG8_SCHED;
            PG8_LDA(At, 1, 1); PG8_STAGE(PG8_SB(1, 0), b3, voffB); PG8_STAGE(PG8_SB(1, 1), b3 + hB, voffB); PG8_STAGE(PG8_SA(1, 0), a3, voffA);
            PG8_WAIT_V(8); PG8_WAIT_L(0); PG8_BAR; PG8_MMA(1, 0, At, B0); PG8_MMA(1, 1, At, B1); PG8_BAR; PG8_SCHED;
        }
        if constexpr (ALIGN_EPI) { if (wr == 0) PG8_BAR; }
        E(acc, cur, wr, wc, fr, fq, xlds);
        if (!has_next) break;
        if constexpr (Epi::INIT_ACC) E.init_acc(acc, nxt, wr, wc, fr, fq);
        else {
#pragma unroll
        for (int a = 0; a < 2; ++a)
#pragma unroll
            for (int b = 0; b < 2; ++b)
#pragma unroll
                for (int m = 0; m < 4; ++m)
#pragma unroll
                    for (int n = 0; n < 2; ++n) acc[a][b][m][n] = (f32x4){0.f, 0.f, 0.f, 0.f};
        }
        cur = nxt; cA = nA; cB = nB; ++ui;
        if constexpr (ALIGN_EPI) { if (wr == 1) PG8_BAR; }
    }
    PG8_WAIT_V(0);
    if constexpr (!ALIGN_EPI) { if (wr == 0) PG8_BAR; }
    PG8_BAR;
#undef PG8_SA
#undef PG8_SB
#undef PG8_STAGE
#undef PG8_LDA
#undef PG8_LDB
#undef PG8_MMA
#undef PG8_WAIT_V
#undef PG8_WAIT_L
#undef PG8_BAR
#undef PG8_SCHED
}
}

namespace att {
constexpr int KBUF = 12288, VBUF = 8192;
constexpr int OFF_K = 0, OFF_V = 4 * KBUF, OFF_C = 4 * KBUF + 4 * VBUF, OFF_U = OFF_C + 1024, ATT_LDS = OFF_U + 64;
__device__ __forceinline__ int crow(int r, int hi) { return (r & 3) + 8 * (r >> 2) + 4 * hi; }
__device__ __forceinline__ s16x4 vtr(const LAS char* p) { typedef short v4i16_t __attribute__((ext_vector_type(4))); return __builtin_bit_cast(s16x4, __builtin_amdgcn_ds_read_tr16_b64_v4i16((LAS v4i16_t*)p)); }
__device__ __forceinline__ float xmax32(float m) { auto rr = __builtin_amdgcn_permlane32_swap(__float_as_uint(m), __float_as_uint(m), false, false); return fmaxf(__uint_as_float(rr[0]), __uint_as_float(rr[1])); }
__device__ __forceinline__ float xsum32(float m) { auto rr = __builtin_amdgcn_permlane32_swap(__float_as_uint(m), __float_as_uint(m), false, false); return __uint_as_float(rr[0]) + __uint_as_float(rr[1]); }
__device__ __forceinline__ void lbar() { asm volatile("s_waitcnt lgkmcnt(0)" ::: "memory"); __builtin_amdgcn_s_barrier(); asm volatile("" ::: "memory"); }

struct Bundle { u32x4 k, v, r; float c; };

template <bool MLA> struct Ctx {
    LAS char* shm; const void *Kn, *Kr, *V, *cum; unsigned kofs, vofs, rofs, cofs, kstep, vstep; int kdst, vdst, rdst, tid;
    __device__ __forceinline__ void load(Bundle& b, int kt, int vt) const {
        b.k = gld<u32x4>(Kn, kofs + (unsigned)kt * kstep); b.v = gld<u32x4>(V, vofs + (unsigned)vt * vstep);
        if (MLA) { if (tid < 256) b.r = gld<u32x4>(Kr, rofs + (unsigned)kt * 4096u); } else { if (tid < 64) b.c = -gld<float>(cum, cofs + (unsigned)kt * 256u); }
    }
    __device__ __forceinline__ void store_k(const Bundle& b, int bi) const {
        *(LAS u32x4*)(shm + OFF_K + bi * KBUF + kdst) = b.k;
        if (MLA) { if (tid < 256) *(LAS u32x4*)(shm + OFF_K + bi * KBUF + rdst) = b.r; } else { if (tid < 64) *(LAS float*)(shm + OFF_C + bi * 256 + tid * 4) = b.c; }
    }
    __device__ __forceinline__ void store(const Bundle& b, int bi) const { store_k(b, bi); *(LAS u32x4*)(shm + OFF_V + bi * VBUF + vdst) = b.v; }
};

template <bool MLA, int NC>
__device__ __forceinline__ void qk_tile(f32x16& s0, f32x16& s1, const LAS char* shm, int bi, const bf16x8 (&qf)[NC], int r, int h) {
    const LAS char* kb = shm + OFF_K + bi * KBUF + h * 1024 + r * 16;
    if (MLA) {
#pragma unroll
        for (int i = 0; i < 16; ++i) { s0[i] = 0.f; s1[i] = 0.f; }
    } else { const LAS float* cb = (const LAS float*)(shm + OFF_C + bi * 256);
#pragma unroll
        for (int g = 0; g < 4; ++g) { const f32x4 c0 = *(const LAS f32x4*)(cb + 8 * g + 4 * h), c1 = *(const LAS f32x4*)(cb + 32 + 8 * g + 4 * h);
#pragma unroll
            for (int e = 0; e < 4; ++e) { s0[4 * g + e] = c0[e]; s1[4 * g + e] = c1[e]; } } }
#pragma unroll
    for (int c = 0; c < NC; ++c) { const bf16x8 a0 = *(const LAS bf16x8*)(kb + c * 2048), a1 = *(const LAS bf16x8*)(kb + c * 2048 + 512);
        s0 = __builtin_amdgcn_mfma_f32_32x32x16_bf16(a0, qf[c], s0, 0, 0, 0); s1 = __builtin_amdgcn_mfma_f32_32x32x16_bf16(a1, qf[c], s1, 0, 0, 0); }
}

__device__ __forceinline__ void softmax_pv(f32x16& s0, f32x16& s1, f32x16& o0, f32x16& o1, float& mrun, float& lrun, const LAS char* shm, int bi, int kv0, int qrow, bool band, int lane, int h) {
    if (band) {
#pragma unroll
        for (int i = 0; i < 16; ++i) { const int kv = kv0 + crow(i, h); if (kv > qrow) s0[i] = -INFINITY; if (kv + 32 > qrow) s1[i] = -INFINITY; }
    }
    float mx = fmaxf(fmaxf(s0[0], s1[0]), fmaxf(s0[1], s1[1]));
#pragma unroll
    for (int i = 2; i < 16; i += 2) mx = fmaxf(fmaxf(mx, s0[i]), fmaxf(fmaxf(s1[i], s0[i + 1]), s1[i + 1]));
    mx = xmax32(mx);
    const float mnew = fmaxf(mrun, mx), alpha = __builtin_amdgcn_exp2f(mrun - mnew); mrun = mnew;
    float ps0 = 0.f, ps1 = 0.f;
#pragma unroll
    for (int i = 0; i < 16; ++i) { s0[i] = __builtin_amdgcn_exp2f(s0[i] - mnew); s1[i] = __builtin_amdgcn_exp2f(s1[i] - mnew); ps0 += s0[i]; ps1 += s1[i]; }
    lrun = lrun * alpha + (ps0 + ps1);
#pragma unroll
    for (int i = 0; i < 16; ++i) { o0[i] *= alpha; o1[i] *= alpha; }
    u32x4 pw[4];
#pragma unroll
    for (int s = 0; s < 2; ++s) {
        pw[s] = (u32x4){pk2(s0[8 * s], s0[8 * s + 1]), pk2(s0[8 * s + 2], s0[8 * s + 3]), pk2(s0[8 * s + 4], s0[8 * s + 5]), pk2(s0[8 * s + 6], s0[8 * s + 7])};
        pw[2 + s] = (u32x4){pk2(s1[8 * s], s1[8 * s + 1]), pk2(s1[8 * s + 2], s1[8 * s + 3]), pk2(s1[8 * s + 4], s1[8 * s + 5]), pk2(s1[8 * s + 6], s1[8 * s + 7])}; }
    const LAS char* vb = shm + OFF_V + bi * VBUF + ((lane >> 4) & 1) * 32 + (lane & 3) * 8 + (4 * h + ((lane & 15) >> 2)) * 64;
#pragma unroll
    for (int ks = 0; ks < 4; ++ks) {
        const s16x4 l0 = vtr(vb + ks * 1024), h0 = vtr(vb + ks * 1024 + 512), l1 = vtr(vb + 4096 + ks * 1024), h1 = vtr(vb + 4096 + ks * 1024 + 512);
        const bf16x8 va0 = __builtin_shufflevector(l0, h0, 0, 1, 2, 3, 4, 5, 6, 7), va1 = __builtin_shufflevector(l1, h1, 0, 1, 2, 3, 4, 5, 6, 7);
        const bf16x8 pb = __builtin_bit_cast(bf16x8, pw[ks]);
        o0 = __builtin_amdgcn_mfma_f32_32x32x16_bf16(va0, pb, o0, 0, 0, 0);
        o1 = __builtin_amdgcn_mfma_f32_32x32x16_bf16(va1, pb, o1, 0, 0, 0);
    }
}

__device__ __forceinline__ void softmax_pv2(f32x16& a0, f32x16& a1, f32x16& b0, f32x16& b1, f32x16& o0, f32x16& o1, float& mrun, float& lrun, const LAS char* shm, int sa, int sb, int lane, int h) {
    float mx = fmaxf(fmaxf(a0[0], a1[0]), fmaxf(b0[0], b1[0]));
#pragma unroll
    for (int i = 1; i < 16; ++i) mx = fmaxf(fmaxf(mx, a0[i]), fmaxf(fmaxf(a1[i], b0[i]), b1[i]));
    mx = xmax32(mx);
    const float mnew = fmaxf(mrun, mx), alpha = __builtin_amdgcn_exp2f(mrun - mnew); mrun = mnew;
    float ps0 = 0.f, ps1 = 0.f, ps2 = 0.f, ps3 = 0.f;
#pragma unroll
    for (int i = 0; i < 16; ++i) { a0[i] = __builtin_amdgcn_exp2f(a0[i] - mnew); a1[i] = __builtin_amdgcn_exp2f(a1[i] - mnew); b0[i] = __builtin_amdgcn_exp2f(b0[i] - mnew); b1[i] = __builtin_amdgcn_exp2f(b1[i] - mnew);
        ps0 += a0[i]; ps1 += a1[i]; ps2 += b0[i]; ps3 += b1[i]; }
    lrun = lrun * alpha + ((ps0 + ps1) + (ps2 + ps3));
#pragma unroll
    for (int i = 0; i < 16; ++i) { o0[i] *= alpha; o1[i] *= alpha; }
    const int vlane = ((lane >> 4) & 1) * 32 + (lane & 3) * 8 + (4 * h + ((lane & 15) >> 2)) * 64;
#pragma unroll
    for (int sub = 0; sub < 2; ++sub) {
        const f32x16& s0 = sub ? b0 : a0; const f32x16& s1 = sub ? b1 : a1;
        u32x4 pw[4];
#pragma unroll
        for (int s = 0; s < 2; ++s) {
            pw[s] = (u32x4){pk2(s0[8 * s], s0[8 * s + 1]), pk2(s0[8 * s + 2], s0[8 * s + 3]), pk2(s0[8 * s + 4], s0[8 * s + 5]), pk2(s0[8 * s + 6], s0[8 * s + 7])};
            pw[2 + s] = (u32x4){pk2(s1[8 * s], s1[8 * s + 1]), pk2(s1[8 * s + 2], s1[8 * s + 3]), pk2(s1[8 * s + 4], s1[8 * s + 5]), pk2(s1[8 * s + 6], s1[8 * s + 7])}; }
        const LAS char* vb = shm + OFF_V + (sub ? sb : sa) * VBUF + vlane;
#pragma unroll
        for (int ks = 0; ks < 4; ++ks) {
            const s16x4 l0 = vtr(vb + ks * 1024), h0 = vtr(vb + ks * 1024 + 512), l1 = vtr(vb + 4096 + ks * 1024), h1 = vtr(vb + 4096 + ks * 1024 + 512);
            const bf16x8 va0 = __builtin_shufflevector(l0, h0, 0, 1, 2, 3, 4, 5, 6, 7), va1 = __builtin_shufflevector(l1, h1, 0, 1, 2, 3, 4, 5, 6, 7);
            const bf16x8 pb = __builtin_bit_cast(bf16x8, pw[ks]);
            o0 = __builtin_amdgcn_mfma_f32_32x32x16_bf16(va0, pb, o0, 0, 0, 0);
            o1 = __builtin_amdgcn_mfma_f32_32x32x16_bf16(va1, pb, o1, 0, 0, 0);
        }
    }
}
template <int NC>
__device__ __forceinline__ void qk_tile_ref(f32x16& s0, f32x16& s1, const f32x16& negm, const LAS char* shm, int bi, const bf16x8 (&qf)[NC], int r, int h) {
    const LAS char* kb = shm + OFF_K + bi * KBUF + h * 1024 + r * 16;
    { const bf16x8 a0 = *(const LAS bf16x8*)(kb), a1 = *(const LAS bf16x8*)(kb + 512);
      s0 = __builtin_amdgcn_mfma_f32_32x32x16_bf16(a0, qf[0], negm, 0, 0, 0); s1 = __builtin_amdgcn_mfma_f32_32x32x16_bf16(a1, qf[0], negm, 0, 0, 0); }
#pragma unroll
    for (int c = 1; c < NC; ++c) { const bf16x8 a0 = *(const LAS bf16x8*)(kb + c * 2048), a1 = *(const LAS bf16x8*)(kb + c * 2048 + 512);
        s0 = __builtin_amdgcn_mfma_f32_32x32x16_bf16(a0, qf[c], s0, 0, 0, 0); s1 = __builtin_amdgcn_mfma_f32_32x32x16_bf16(a1, qf[c], s1, 0, 0, 0); }
}
__device__ __forceinline__ void softmax_pv2_def(f32x16& a0, f32x16& a1, f32x16& b0, f32x16& b1, f32x16& o0, f32x16& o1, f32x16& negm, float& mrun, float& lrun, const LAS char* shm, int sa, int sb, int lane, int h) {
    float mx = fmaxf(fmaxf(a0[0], a1[0]), fmaxf(b0[0], b1[0]));
#pragma unroll
    for (int i = 1; i < 16; ++i) mx = fmaxf(fmaxf(mx, a0[i]), fmaxf(fmaxf(a1[i], b0[i]), b1[i]));
    mx = xmax32(mx);
    if (__any(mx > 8.f)) {
        const float dl = fmaxf(mx, 0.f), alpha = __builtin_amdgcn_exp2f(-dl); mrun += dl; lrun *= alpha;
#pragma unroll
        for (int i = 0; i < 16; ++i) { a0[i] -= dl; a1[i] -= dl; b0[i] -= dl; b1[i] -= dl; o0[i] *= alpha; o1[i] *= alpha; negm[i] = -mrun; }
    }
    float ps0 = 0.f, ps1 = 0.f, ps2 = 0.f, ps3 = 0.f;
#pragma unroll
    for (int i = 0; i < 16; ++i) { a0[i] = __builtin_amdgcn_exp2f(a0[i]); a1[i] = __builtin_amdgcn_exp2f(a1[i]); b0[i] = __builtin_amdgcn_exp2f(b0[i]); b1[i] = __builtin_amdgcn_exp2f(b1[i]);
        ps0 += a0[i]; ps1 += a1[i]; ps2 += b0[i]; ps3 += b1[i]; }
    lrun += (ps0 + ps1) + (ps2 + ps3);
    const int vlane = ((lane >> 4) & 1) * 32 + (lane & 3) * 8 + (4 * h + ((lane & 15) >> 2)) * 64;
#pragma unroll
    for (int sub = 0; sub < 2; ++sub) {
        const f32x16& s0 = sub ? b0 : a0; const f32x16& s1 = sub ? b1 : a1;
        u32x4 pw[4];
#pragma unroll
        for (int s = 0; s < 2; ++s) {
            pw[s] = (u32x4){pk2(s0[8 * s], s0[8 * s + 1]), pk2(s0[8 * s + 2], s0[8 * s + 3]), pk2(s0[8 * s + 4], s0[8 * s + 5]), pk2(s0[8 * s + 6], s0[8 * s + 7])};
            pw[2 + s] = (u32x4){pk2(s1[8 * s], s1[8 * s + 1]), pk2(s1[8 * s + 2], s1[8 * s + 3]), pk2(s1[8 * s + 4], s1[8 * s + 5]), pk2(s1[8 * s + 6], s1[8 * s + 7])}; }
        const LAS char* vb = shm + OFF_V + (sub ? sb : sa) * VBUF + vlane;
#pragma unroll
        for (int ks = 0; ks < 4; ++ks) {
            const s16x4 l0 = vtr(vb + ks * 1024), h0 = vtr(vb + ks * 1024 + 512), l1 = vtr(vb + 4096 + ks * 1024), h1 = vtr(vb + 4096 + ks * 1024 + 512);
            const bf16x8 va0 = __builtin_shufflevector(l0, h0, 0, 1, 2, 3, 4, 5, 6, 7), va1 = __builtin_shufflevector(l1, h1, 0, 1, 2, 3, 4, 5, 6, 7);
            const bf16x8 pb = __builtin_bit_cast(bf16x8, pw[ks]);
            o0 = __builtin_amdgcn_mfma_f32_32x32x16_bf16(va0, pb, o0, 0, 0, 0);
            o1 = __builtin_amdgcn_mfma_f32_32x32x16_bf16(va1, pb, o1, 0, 0, 0);
        }
    }
}
__device__ __forceinline__ void mask_tile(f32x16& s0, f32x16& s1, int kv0, int qrow, int h) {
#pragma unroll
    for (int i = 0; i < 16; ++i) { const int kv = kv0 + crow(i, h); if (kv > qrow) s0[i] = -INFINITY; if (kv + 32 > qrow) s1[i] = -INFINITY; }
}

template <bool MLA>
__device__ __forceinline__ void attn_unit(LAS char* shm, int b, int hd, int qb,
        const bf16_t* Q, int pq, int qoff, const bf16_t* Kn, int pk, int koff, const bf16_t* Kr,
        const bf16_t* V, int pv, int voff, const float* cum, bf16_t* O, int po, int ooff, int T0) {
    constexpr int NC = MLA ? 6 : 4;
    int tid_o = threadIdx.x; asm volatile("" : "+v"(tid_o));
    const int tid = tid_o, lane = tid & 63, r = lane & 31, h = lane >> 5; const int wid = __builtin_amdgcn_readfirstlane(tid >> 6);
    const unsigned rowbase = (unsigned)b * SEQ; const int q0 = qb * 256; const int NT2 = (q0 + 256) / 128;
    const int lkey = tid >> 3, lch = tid & 7;
    Ctx<MLA> C;
    C.shm = shm; C.Kn = Kn; C.Kr = Kr; C.V = V; C.cum = cum; C.tid = tid;
    C.kofs = ((rowbase + lkey) * (unsigned)pk + koff + lch * 8) * 2u; C.kstep = 64u * (unsigned)pk * 2u;
    C.vofs = ((rowbase + lkey) * (unsigned)pv + voff + lch * 8) * 2u; C.vstep = 64u * (unsigned)pv * 2u;
    C.rofs = ((rowbase + (tid >> 2)) * 32u + (tid & 3) * 8) * 2u;
    C.cofs = ((unsigned)(b * 6 + hd) * SEQ + (tid & 63)) * 4u;
    C.kdst = lch * 1024 + lkey * 16;
    C.vdst = (lch >> 2) * 4096 + (lkey >> 4) * 1024 + ((lkey >> 3) & 1) * 512 + (lkey & 7) * 64 + (lch & 3) * 16;
    C.rdst = (8 + (tid & 3)) * 1024 + (tid >> 2) * 16;
    const int qrow = q0 + wid * 32 + r, qlast = q0 + wid * 32 + 31, qfirst = q0 + wid * 32;
    bf16x8 qf[NC];
    { const unsigned qo = ((rowbase + qrow) * (unsigned)pq + qoff + 8 * h) * 2u;
#pragma unroll
      for (int c = 0; c < NC; ++c) qf[c] = gld<bf16x8>(Q, qo + 32 * c); }
    f32x16 o0, o1, sA0, sA1, sB0, sB1, negm;
#pragma unroll
    for (int i = 0; i < 16; ++i) { o0[i] = 0.f; o1[i] = 0.f; negm[i] = 0.f; }
    float mrun = -INFINITY, lrun = 0.f;
    Bundle bA, bB; bA.r = (u32x4){0u, 0u, 0u, 0u}; bB.r = bA.r; bA.c = 0.f; bB.c = 0.f;
    C.load(bA, 2 * T0, 2 * T0); C.load(bB, 2 * T0 + 1, 2 * T0 + 1);
    C.store(bA, 2 * (T0 & 1)); C.store(bB, 2 * (T0 & 1) + 1);
    lbar();
#define ATT_ITER(T_, MODE) do { const int T = (T_); const int sa = 2 * (T & 1), sb = sa + 1, t0 = 2 * T; \
        if (T + 1 < NT2) { C.load(bA, t0 + 2, t0 + 2); C.load(bB, t0 + 3, t0 + 3); } \
        if (MODE == 0) { \
            qk_tile<MLA, NC>(sA0, sA1, shm, sa, qf, r, h); qk_tile<MLA, NC>(sB0, sB1, shm, sb, qf, r, h); \
            softmax_pv2(sA0, sA1, sB0, sB1, o0, o1, mrun, lrun, shm, sa, sb, lane, h); \
        } else if (MODE == 1) { \
            qk_tile_ref<NC>(sA0, sA1, negm, shm, sa, qf, r, h); qk_tile_ref<NC>(sB0, sB1, negm, shm, sb, qf, r, h); \
            softmax_pv2_def(sA0, sA1, sB0, sB1, o0, o1, negm, mrun, lrun, shm, sa, sb, lane, h); \
        } else if (64 * t0 <= qlast) { \
            qk_tile<MLA, NC>(sA0, sA1, shm, sa, qf, r, h); \
            if (64 * t0 + 63 > qfirst) mask_tile(sA0, sA1, 64 * t0, qrow, h); \
            if (64 * (t0 + 1) <= qlast) { qk_tile<MLA, NC>(sB0, sB1, shm, sb, qf, r, h); if (64 * (t0 + 1) + 63 > qfirst) mask_tile(sB0, sB1, 64 * (t0 + 1), qrow, h); } \
            else { _Pragma("unroll") for (int i = 0; i < 16; ++i) { sB0[i] = -INFINITY; sB1[i] = -INFINITY; } } \
            softmax_pv2(sA0, sA1, sB0, sB1, o0, o1, mrun, lrun, shm, sa, sb, lane, h); \
        } \
        if (T + 1 < NT2) { C.store(bA, sa ^ 2); C.store(bB, sb ^ 2); } \
        lbar(); } while (0)
    int Tc = T0;
    if (Tc < NT2 - 2) { ATT_ITER(Tc, 0); ++Tc;
        if (MLA) {
#pragma unroll
            for (int i = 0; i < 16; ++i) negm[i] = -mrun; } }
    for (; Tc < NT2 - 2; ++Tc) ATT_ITER(Tc, (MLA ? 1 : 0));
    for (; Tc < NT2; ++Tc) ATT_ITER(Tc, 2);
#undef ATT_ITER
    lrun = xsum32(lrun);
    const float inv = 1.f / lrun;
    const unsigned oo = ((rowbase + qrow) * (unsigned)po + ooff + 4 * h) * 2u;
#pragma unroll
    for (int g = 0; g < 4; ++g) {
        u32x2 w0 = {pk2(o0[4 * g] * inv, o0[4 * g + 1] * inv), pk2(o0[4 * g + 2] * inv, o0[4 * g + 3] * inv)};
        u32x2 w1 = {pk2(o1[4 * g] * inv, o1[4 * g + 1] * inv), pk2(o1[4 * g + 2] * inv, o1[4 * g + 3] * inv)};
        gst<u32x2>(O, oo + 16 * g, w0); gst<u32x2>(O, oo + 64 + 16 * g, w1); }
}
}

#ifndef REP_MASK
#define REP_MASK 0
#endif
#ifndef PHASE_MASK
#define PHASE_MASK 0xfff
#endif
constexpr int NWAVES = 8, NTHREADS = 512;
constexpr size_t MiB = 1u << 20;
constexpr size_t WS_CTL = 0;
constexpr size_t ZERO_BYTES = 64 * 1024;
constexpr size_t WS_CS = 2 * MiB;
constexpr size_t WS_CUM = 6 * MiB;
constexpr size_t WS_FF = 7 * MiB;
constexpr size_t WS_KROPE = 8 * MiB;
constexpr size_t WS_SS = 10 * MiB;
constexpr size_t WS_W = 30 * MiB;
constexpr size_t W_IN = WS_W, W_UQ = W_IN + (size_t)NIN * DM * 2, W_UKV = W_UQ + (size_t)768 * 256 * 2, W_OUT = W_UKV + (size_t)768 * 128 * 2,
                 W_UP = W_OUT + (size_t)DM * DM * 2, W_DOWN = W_UP + (size_t)NUP * DM * 2, W_PG = W_DOWN + (size_t)DM * DFF * 2, W_PLE = W_PG + (size_t)DM * DM * 2, W_END = W_PLE + (size_t)DM * PLE * 2;
static_assert(W_END <= 58 * MiB, "weights region");
constexpr size_t WS_HBX = 58 * MiB;
constexpr size_t WS_PB = 122 * MiB;
constexpr size_t WS_R = 138 * MiB;
constexpr size_t WS_Z = WS_R, WS_Q = WS_R + 160 * MiB, WS_KV = WS_R + 196 * MiB, WS_OM = WS_R + 244 * MiB, WS_OF = WS_R + 268 * MiB, WS_MIX = WS_R + 292 * MiB;
constexpr size_t WS_ACT = WS_R + 176 * MiB, WS_T = WS_R;
constexpr size_t WS_END = 512 * MiB;
static_assert(WS_MIX + 64 * MiB <= WS_END && WS_ACT + 176 * MiB <= WS_END, "ws map");
constexpr int LDS_BYTES = 163840;
constexpr int RING_BYTES = 131072, XL_OFF = RING_BYTES + 1024;

#define RLX_AGENT __ATOMIC_RELAXED, __HIP_MEMORY_SCOPE_AGENT
#define XB_TMO      128
#define XB_XCNT(j)  (256  + 64 * (j))
#define XB_XSUB(j)  (1280 + 64 * (j))
#define XB_XGEN(j)  (2304 + 64 * (j))
#define XB_TOP      3328
#define XB_TOPGEN   3392
#define XCD_BAR_WORDS 3456
#define XB_SPIN_CAP (1u << 18)

__device__ __forceinline__ unsigned xb_ld(unsigned* p)              { return __hip_atomic_load(p, __ATOMIC_RELAXED, __HIP_MEMORY_SCOPE_AGENT); }
__device__ __forceinline__ unsigned xb_add(unsigned* p, unsigned v) { return __hip_atomic_fetch_add(p, v, __ATOMIC_RELAXED, __HIP_MEMORY_SCOPE_AGENT); }
__device__ __forceinline__ unsigned xb_xcc_id() { return (unsigned)__builtin_amdgcn_s_getreg((3 << 11) | 20) & 0xFu; }
#define XB_SPIN(cond, bar) do { unsigned _sp = 0; while (cond) { __builtin_amdgcn_s_sleep(1); \
    if ((++_sp & 255u) == 0u) { if (xb_ld(&(bar)[XB_TMO])) break; if (_sp > XB_SPIN_CAP) { atomicAdd(&(bar)[XB_TMO], 1u); break; } } } } while (0)

struct XcdBarrier {
    unsigned* bar; unsigned x;
    volatile LAS unsigned* st;
};

__device__ __forceinline__ XcdBarrier xcd_barrier_post(unsigned* bar, volatile LAS unsigned* st) {
    XcdBarrier b; b.bar = bar; b.x = xb_xcc_id(); b.st = st;
    if (threadIdx.x == 0) (void)xb_add(&bar[XB_XCNT(b.x)], 1u);
    return b;
}
__device__ __forceinline__ void xcd_barrier_complete(unsigned* bar, unsigned x, unsigned& nloc, unsigned& nx) {
    const unsigned G = gridDim.x * gridDim.y * gridDim.z;
    unsigned sum, cnt, mine, sp = 0u;
    for (;;) {
        sum = 0u; cnt = 0u; mine = 0u;
#pragma unroll
        for (unsigned j = 0; j < 16; ++j) { const unsigned c = xb_ld(&bar[XB_XCNT(j)]); sum += c; cnt += (c > 0u) ? 1u : 0u; mine = (j == x) ? c : mine; }
        if (sum == G) break;
        __builtin_amdgcn_s_sleep(1);
        if ((++sp & 255u) == 0u) { if (xb_ld(&bar[XB_TMO])) break; if (sp > XB_SPIN_CAP) { atomicAdd(&bar[XB_TMO], 1u); break; } }
    }
    nloc = mine > 0u ? mine : 1u; nx = cnt > 0u ? cnt : 1u;
}

__device__ __forceinline__ void xcd_barrier(const XcdBarrier& b) {
    asm volatile("s_waitcnt vmcnt(0)" ::: "memory");
    __syncthreads();
    if (threadIdx.x == 0) {
        unsigned* bar = b.bar;
        __builtin_amdgcn_s_waitcnt(0);
        unsigned nloc = b.st[0], nx = b.st[1];
        if (nloc == 0u) { xcd_barrier_complete(bar, b.x, nloc, nx); b.st[0] = nloc; b.st[1] = nx; }
        const unsigned old = xb_add(&bar[XB_XSUB(b.x)], 1u);
        const unsigned gen = old / nloc;
        if (old + 1u == (gen + 1u) * nloc) {
            __builtin_amdgcn_fence(__ATOMIC_RELEASE, "agent");
            asm volatile("s_waitcnt vmcnt(0)" ::: "memory");
            const unsigned og = xb_add(&bar[XB_TOP], 1u);
            const unsigned tg = og / nx;
            if (og + 1u == (tg + 1u) * nx) xb_add(&bar[XB_TOPGEN], 1u);
            else XB_SPIN(xb_ld(&bar[XB_TOPGEN]) == tg, bar);
            __builtin_amdgcn_fence(__ATOMIC_ACQUIRE, "agent");
            xb_add(&bar[XB_XGEN(b.x)], 1u);
            asm volatile("s_waitcnt vmcnt(0)" ::: "memory");
        } else {
            XB_SPIN(xb_ld(&bar[XB_XGEN(b.x)]) == gen, bar);
            __builtin_amdgcn_fence(__ATOMIC_ACQUIRE, "agent");
            asm volatile("s_waitcnt vmcnt(0)" ::: "memory");
        }
    }
    __syncthreads();
}

struct Args {
    const float* in[24]; float* out; unsigned char* ws; float inv_freq[16];
};

struct MapId { int n; __device__ __forceinline__ int operator()(int d) const { return d < n ? d : -1; } };
struct MapIn { __device__ __forceinline__ int operator()(int d) const {
    if (d < 384) return d;
    if (d < 416) { const int j = (d - 384) >> 1, e = (d - 384) & 1; return 384 + 16 * e + j; }
    if (d < 422) return 2336 + (d - 416);
    if (d < 512) return -1;
    if (d < 1280) return 416 + (d - 512);
    if (d < 2432) return 1184 + (d - 1280);
    return -1; } };
struct MapUq { __device__ __forceinline__ int operator()(int d) const {
    if (d >= QW) return -1; const int hd = d / 96, w = d % 96; if (w < 64) return d; const int j = (w - 64) >> 1, e = (w - 64) & 1; return 96 * hd + 64 + 16 * e + j; } };
struct MapUp { __device__ __forceinline__ int operator()(int d) const { const int tile = d >> 8, w = d & 255; return w < 128 ? 128 * tile + w : DFF + 128 * tile + (w - 128); } };
struct GainNone { __device__ __forceinline__ float operator()(int) const { return 1.f; } };
struct GainVec { const float* g; __device__ __forceinline__ float operator()(int k) const { return g[k]; } };
struct GainMix { const float *a, *b, *c; __device__ __forceinline__ float operator()(int k) const { return k < 384 ? a[k] : (k < 640 ? b[k - 384] : c[k - 640]); } };

template <class Map, class Gain>
__device__ __forceinline__ void transpose_item(const float* __restrict__ W, int K, int Nsrc, bf16_t* __restrict__ WT, int nblk, LAS float* scr, int item, int lane, Map map, Gain gain) {
    const int kb = item / nblk, nb = item % nblk, k0 = 64 * kb, n0 = 32 * nb;
    const int src = map(n0 + (lane & 31));
    float wv[32];
#pragma unroll
    for (int i = 0; i < 32; ++i) { const int kk = 2 * i + (lane >> 5); wv[i] = src >= 0 ? W[(size_t)(k0 + kk) * Nsrc + src] : 0.f; }
#pragma unroll
    for (int i = 0; i < 32; ++i) { const int kk = 2 * i + (lane >> 5); scr[kk * 33 + (lane & 31)] = wv[i] * gain(k0 + kk); }
    asm volatile("s_waitcnt lgkmcnt(0)" ::: "memory");
    const int c = lane & 7;
#pragma unroll
    for (int j = 0; j < 4; ++j) { const int n = (lane >> 3) + 8 * j; const LAS float* s = scr + (8 * c) * 33 + n;
        u32x4 o; o.x = pk2(s[0 * 33], s[1 * 33]); o.y = pk2(s[2 * 33], s[3 * 33]); o.z = pk2(s[4 * 33], s[5 * 33]); o.w = pk2(s[6 * 33], s[7 * 33]);
        *(u32x4*)(WT + (size_t)(n0 + n) * K + k0 + 8 * c) = o; }
    asm volatile("s_waitcnt lgkmcnt(0)" ::: "memory");
}

__global__ void __launch_bounds__(NTHREADS, 2) hymba_fwd(Args args) {
    extern __shared__ __attribute__((aligned(16))) unsigned char lds_raw[];
    LAS unsigned char* lds = (LAS unsigned char*)lds_raw;
    cg::grid_group grid = cg::this_grid();
    const int G = gridDim.x, bid = blockIdx.x;
    { volatile LAS unsigned* misc = (volatile LAS unsigned*)(lds + RING_BYTES); if (threadIdx.x < 16) misc[threadIdx.x] = 0u; __syncthreads(); }
    (void)xcd_barrier_post((unsigned*)(args.ws + WS_CTL) + 4096, (volatile LAS unsigned*)(lds + RING_BYTES) + 8);
#define GSYNC() do { XcdBarrier xb_; unsigned char* w_ = args.ws; asm volatile("" : "+s"(w_)); xb_.bar = (unsigned*)(w_ + WS_CTL) + 4096; xb_.x = xb_xcc_id(); xb_.st = (volatile LAS unsigned*)(lds + RING_BYTES) + 8; xcd_barrier(xb_); } while (0)
#define NGW (G * NWAVES)
#define NGT (G * NTHREADS)
#define PH_IDS int tid_o = threadIdx.x; asm volatile("" : "+v"(tid_o)); const int tid = tid_o, lane = tid & 63, wave = __builtin_amdgcn_readfirstlane(tid >> 6); \
    const int gw = bid * NWAVES + wave, gtid = bid * NTHREADS + tid; (void)gw; (void)gtid; (void)lane; \
    unsigned char* ws = args.ws; asm volatile("" : "+s"(ws));
#define ws_ ws
#define P_x ((const float*)args.in[0])
#define P_p_in ((const float*)args.in[1])
#define P_positions ((const int*)args.in[2])
#define P_out (args.out)
#define P_ctl ((unsigned*)(ws + WS_CTL))
#define P_ssb ((float*)(ws + WS_SS))
#define P_cs ((float*)(ws + WS_CS))
#define P_cum ((float*)(ws + WS_CUM))
#define P_ffbuf ((float*)(ws + WS_FF))
#define P_krope ((bf16_t*)(ws + WS_KROPE))
#define P_Win ((bf16_t*)(wb + (W_IN - WS_W)))
#define P_Wuq ((bf16_t*)(wb + (W_UQ - WS_W)))
#define P_Wukv ((bf16_t*)(wb + (W_UKV - WS_W)))
#define P_Wout ((bf16_t*)(wb + (W_OUT - WS_W)))
#define P_Wup ((bf16_t*)(wb + (W_UP - WS_W)))
#define P_Wdown ((bf16_t*)(wb + (W_DOWN - WS_W)))
#define P_Wpg ((bf16_t*)(wb + (W_PG - WS_W)))
#define P_Wple ((bf16_t*)(wb + (W_PLE - WS_W)))
#define P_hbX ((bf16_t*)(ws + WS_HBX))
#define P_hbY ((bf16_t*)args.out)
#define P_hbZ ((bf16_t*)(ws + WS_ACT))
#define P_pb ((bf16_t*)pbb)
#define P_zb ((bf16_t*)(ws + WS_Z))
#define P_qb_ ((bf16_t*)(ws + WS_Q))
#define P_kvb ((bf16_t*)(ws + WS_KV))
#define P_omla ((bf16_t*)(ws + WS_OM))
#define P_ofox ((bf16_t*)(ws + WS_OF))
#define P_mixed ((bf16_t*)(ws + WS_MIX))
#define P_act ((bf16_t*)(ws + WS_ACT))
#define P_tb ((bf16_t*)(ws + WS_T))
#define P_ss_attn (P_ssb + (size_t)(L * 5 + 0) * MROWS * 16)
#define P_ss_q (P_ssb + (size_t)(L * 5 + 1) * MROWS * 16)
#define P_ss_kv (P_ssb + (size_t)(L * 5 + 2) * MROWS * 16)
#define P_ss_ffn (P_ssb + (size_t)(L * 5 + 3) * MROWS * 16)
#define P_ss_ple (P_ssb + (size_t)(L * 5 + 4) * MROWS * 16)
#define P_ss_next (P_ssb + (size_t)((L + 1) % DEPTH * 5 + 0) * MROWS * 16)

#define LAYER_WB(l) ((l) == 0 ? ws + WS_W : (unsigned char*)args.out + (64u << 20))
#define LAYER_PB(l) ((l) == 0 ? ws + WS_PB : (unsigned char*)args.out + (92u << 20))
#define PH_IDS_L PH_IDS unsigned char* wb = LAYER_WB(L); unsigned char* pbb = LAYER_PB(L); (void)wb; (void)pbb;
    for (int L = 0; L < DEPTH; ++L) {
        for (int rep = 0; rep < 1 + ((REP_MASK >> 0) & 1); ++rep) { if (rep) GSYNC();
        if ((PHASE_MASK & (1 << 0)) && L == 0) { PH_IDS_L
            LAS float* scr = (LAS float*)(lds + wave * 16384);
            for (int Lw = 0; Lw < DEPTH; ++Lw) { unsigned char* wb = LAYER_WB(Lw); unsigned char* pbb = LAYER_PB(Lw);
            const float* attn_norm = args.in[3] + (size_t)Lw * DM; const float* w_in = args.in[4] + (size_t)Lw * DM * NIN_SRC;
            const float* q_norm = args.in[6] + (size_t)Lw * 256; const float* w_uq = args.in[7] + (size_t)Lw * 256 * QW;
            const float* kv_norm = args.in[8] + (size_t)Lw * 128; const float* w_ukv = args.in[9] + (size_t)Lw * 128 * KVW;
            const float* mla_on = args.in[11] + (size_t)Lw * 384; const float* conv_on = args.in[12] + (size_t)Lw * 256; const float* fox_on = args.in[13] + (size_t)Lw * 384;
            const float* w_out = args.in[14] + (size_t)Lw * DM * DM; const float* ffn_norm = args.in[15] + (size_t)Lw * DM; const float* w_up = args.in[16] + (size_t)Lw * DM * NUP;
            const float* w_down = args.in[19] + (size_t)Lw * DFF * DM; const float* ple_norm = args.in[20] + (size_t)Lw * DM; const float* w_pg = args.in[21] + (size_t)Lw * DM * DM;
            const float* w_ple = args.in[22] + (size_t)Lw * PLE * DM;
            constexpr int I_IN = (DM / 64) * (NIN / 32), I_UQ = (256 / 64) * (768 / 32), I_UKV = (128 / 64) * (768 / 32), I_OUT = (DM / 64) * (DM / 32), I_UP = (DM / 64) * (NUP / 32),
                          I_DOWN = (DFF / 64) * (DM / 32), I_PG = I_OUT, I_PLE = (PLE / 64) * (DM / 32);
            constexpr int NITEMS = I_IN + I_UQ + I_UKV + I_OUT + I_UP + I_DOWN + I_PG + I_PLE;
            for (int it = gw; it < NITEMS; it += NGW) {
                int r = it;
                if (r < I_UP) { transpose_item(w_up, DM, NUP, P_Wup, NUP / 32, scr, r, lane, MapUp{}, GainVec{ffn_norm}); continue; } r -= I_UP;
                if (r < I_DOWN) { transpose_item(w_down, DFF, DM, P_Wdown, DM / 32, scr, r, lane, MapId{DM}, GainNone{}); continue; } r -= I_DOWN;
                if (r < I_IN) { transpose_item(w_in, DM, NIN_SRC, P_Win, NIN / 32, scr, r, lane, MapIn{}, GainVec{attn_norm}); continue; } r -= I_IN;
                if (r < I_OUT) { transpose_item(w_out, DM, DM, P_Wout, DM / 32, scr, r, lane, MapId{DM}, GainMix{mla_on, conv_on, fox_on}); continue; } r -= I_OUT;
                if (r < I_PG) { transpose_item(w_pg, DM, DM, P_Wpg, DM / 32, scr, r, lane, MapId{DM}, GainVec{ple_norm}); continue; } r -= I_PG;
                if (r < I_UQ) { transpose_item(w_uq, 256, QW, P_Wuq, 768 / 32, scr, r, lane, MapUq{}, GainVec{q_norm}); continue; } r -= I_UQ;
                if (r < I_UKV) { transpose_item(w_ukv, 128, KVW, P_Wukv, 768 / 32, scr, r, lane, MapId{KVW}, GainVec{kv_norm}); continue; } r -= I_UKV;
                transpose_item(w_ple, PLE, DM, P_Wple, DM / 32, scr, r, lane, MapId{DM}, GainNone{});
            }
            { const float* pl = P_p_in + (size_t)Lw * MROWS * PLE;
              for (size_t i = gtid; i < (size_t)MROWS * PLE / 8; i += NGT) { const f32x4 a = *(const f32x4*)(pl + i * 8), b = *(const f32x4*)(pl + i * 8 + 4); *(u32x4*)(P_pb + i * 8) = pg8::pack8(a, b); } }
            }
            if (L == 0) {
                { constexpr int RB = 4; const void* x_ = P_x; void* hy_ = P_hbY; float* ssa_ = P_ss_attn;
                  for (int m0 = gw; m0 < MROWS; m0 += RB * NGW) { float sm[RB]; f32x4 v[RB][4];
#pragma unroll
                    for (int k = 0; k < RB; ++k) { const unsigned m = (unsigned)min(m0 + k * NGW, MROWS - 1); sm[k] = 0.f;
#pragma unroll
                        for (int jj = 0; jj < 4; ++jj) { v[k][jj] = gld<f32x4>(x_, m * 4096u + (lane + 64 * jj) * 16); sm[k] += (v[k][jj].x * v[k][jj].x + v[k][jj].y * v[k][jj].y) + (v[k][jj].z * v[k][jj].z + v[k][jj].w * v[k][jj].w); } }
#pragma unroll
                    for (int o = 1; o < 64; o <<= 1) {
#pragma unroll
                        for (int k = 0; k < RB; ++k) sm[k] += __shfl_xor(sm[k], o); }
#pragma unroll
                    for (int k = 0; k < RB; ++k) { const unsigned m = (unsigned)min(m0 + k * NGW, MROWS - 1);
#pragma unroll
                        for (int jj = 0; jj < 4; ++jj) gst<u32x2>(hy_, m * 2048u + (lane + 64 * jj) * 8, (u32x2){pk2(v[k][jj].x, v[k][jj].y), pk2(v[k][jj].z, v[k][jj].w)});
                        if (lane == 0) ssa_[(size_t)m * 16] = sm[k]; } } }
                for (int i = gtid; i < MROWS * 16; i += NGT) {
                    const int m = i >> 4, j = i & 15; const float ang = (float)P_positions[m] * args.inv_freq[j];
                    const double rev = (double)ang * 0.15915494309189535; const float fr = (float)(rev - rint(rev));
                    P_cs[2 * i] = __builtin_amdgcn_cosf(fr); P_cs[2 * i + 1] = __builtin_amdgcn_sinf(fr);
                }
            }
        } }
        if (L == 0) { if (args.out == nullptr) grid.sync(); GSYNC(); }
        for (int rep = 0; rep < 1 + ((REP_MASK >> 1) & 1); ++rep) { if (rep) GSYNC();
        if (PHASE_MASK & (1 << 1)) { PH_IDS_L
            pg8::Gemm g{P_hbY, P_Win, MROWS, NIN, DM, DM, DM, 256, 0}; pg8::StaticOrder S; S.init(MROWS, NIN, G, bid);
            pg8::EpiZ E{P_zb, P_ss_attn, L == 0 ? 1 : 16, P_ss_q, P_ss_kv, P_ffbuf, P_krope, P_cs, P_ctl + 128 + 64 * L};
            pg8::gemm_phase<pg8::EpiZ, pg8::StaticOrder, true>(lds, lds + XL_OFF, g, S, E);
        } }
        GSYNC();
        for (int rep = 0; rep < 1 + ((REP_MASK >> 2) & 1); ++rep) { if (rep) GSYNC();
        if (PHASE_MASK & (1 << 2)) { PH_IDS_L
            { pg8::Gemm g{P_zb, P_Wuq, MROWS, 768, 256, NIN, 256, 256, 0}; pg8::StaticOrder S; S.init(MROWS, 768, G, bid);
              pg8::EpiQ E{P_qb_, P_ss_q, P_cs}; pg8::gemm_phase<pg8::EpiQ, pg8::StaticOrder, true>(lds, lds + XL_OFF, g, S, E); }
            { pg8::Gemm g{P_zb + 256, P_Wukv, MROWS, 768, 128, NIN, 128, 256, 0}; pg8::StaticOrder S; S.init(MROWS, 768, G, (bid + G / 2) % G);
              pg8::EpiRowScale E{P_kvb, KVW, P_ss_kv, 4, 1.f / 128.f, 1.f}; pg8::gemm_phase<pg8::EpiRowScale, pg8::StaticOrder, true>(lds, lds + XL_OFF, g, S, E); }
            const float* bfg = args.in[5] + (size_t)L * 6;
            for (int bh = (bid + G - G / 2) % G; bh < 48; bh += G) {
                const int b = bh / 6, hd = bh % 6; const float bf = bfg[hd]; const int s0 = tid * 8;
                float v[8]; float run = 0.f;
#pragma unroll
                for (int e = 0; e < 8; ++e) { const float xv = P_ffbuf[((size_t)b * SEQ + s0 + e) * 8 + hd] + bf; const float ls = fminf(xv, 0.f) - __logf(1.f + __expf(-fabsf(xv))); run += ls * LOG2E; v[e] = run; }
                float tot = run;
#pragma unroll
                for (int o = 1; o < 64; o <<= 1) { const float tt = __shfl_up(tot, o); if (lane >= o) tot += tt; }
                LAS float* wsum = (LAS float*)lds;
                __syncthreads();
                if (lane == 63) wsum[wave] = tot;
                __syncthreads();
                float off = tot - run;
                for (int w = 0; w < wave; ++w) off += wsum[w];
#pragma unroll
                for (int e = 0; e < 8; ++e) P_cum[(size_t)bh * SEQ + s0 + e] = off + v[e];
                __syncthreads();
            }
        } }
        GSYNC();
        for (int rep = 0; rep < 1 + ((REP_MASK >> 3) & 1); ++rep) { if (rep) GSYNC();
          if (PHASE_MASK & (1 << 3)) { PH_IDS_L
            LAS int* ubox = (LAS int*)(lds + att::OFF_U);
            const int home = (int)(xb_xcc_id() & 7u);
            int qi = 0, xq = home, u;
#define ATT_POP_SYNC() do { if (tid == 0) ubox[0] = (int)atomicAdd(P_ctl + 64 * L + 16 * rep + xq, 1u); __syncthreads(); u = ubox[0]; __syncthreads(); } while (0)
            ATT_POP_SYNC();
            for (;;) {
                while (u >= 192 && ++qi < 8) { xq = (home + qi) & 7; ATT_POP_SYNC(); }
                if (u >= 192) break;
                unsigned pnext = 0u; if (tid == 0) pnext = atomicAdd(P_ctl + 64 * L + 16 * rep + xq, 1u);
                {
                    const int type = u >= 96, ui = type ? u - 96 : u, qb = 15 - ui / 6, bh = xq * 6 + ui % 6, b = bh / 6, hd = bh % 6;
                    if (type == 0) att::attn_unit<true>((LAS char*)lds, b, hd, qb, P_qb_, QW, hd * 96, P_kvb, KVW, hd * 128, P_krope, P_kvb, KVW, hd * 128 + 64, P_cum, P_omla, 384, hd * 64, 0);
                    else {
                        const unsigned* nbw = P_ctl + 128 + 64 * L + bh;
                        const float Bq = 1.01f * sqrtf((__uint_as_float(nbw[0]) + __uint_as_float(nbw[256])) * (__uint_as_float(nbw[128]) + __uint_as_float(nbw[384])));
                        const float thr = -(64.f + 2.f * Bq); const float* cu = P_cum + (size_t)bh * SEQ; const float cq = cu[qb * 256];
                        const int it_ = lane & 31; const bool sk = it_ < 2 * qb && (cq - cu[128 * (it_ < 2 * qb ? it_ : 0) + 127] < thr);
                        const int lo = __popcll(__ballot(sk) & 0xffffffffull);
                        att::attn_unit<false>((LAS char*)lds, b, hd, qb, P_zb, NIN, ZC_FQ + hd * 64, P_zb, NIN, ZC_FK + hd * 64, P_krope, P_zb, NIN, ZC_FV + hd * 64, P_cum, P_ofox, 384, hd * 64, lo);
                    }
                }
                if (tid == 0) ubox[0] = (int)pnext;
                __syncthreads(); u = ubox[0]; __syncthreads();
            }
#undef ATT_POP_SYNC
          }
        }
        GSYNC();
        for (int rep = 0; rep < 1 + ((REP_MASK >> 4) & 1); ++rep) { if (rep) GSYNC();
        if (PHASE_MASK & (1 << 4)) { PH_IDS_L
            const float* cw = args.in[10] + (size_t)L * 3 * 256;
            const f32x4 w0 = *(const f32x4*)(cw + 4 * lane), w1 = *(const f32x4*)(cw + 256 + 4 * lane), w2 = *(const f32x4*)(cw + 512 + 4 * lane);
            constexpr int RB = 4;
            const void *om_ = P_omla, *of_ = P_ofox, *zb_ = P_zb; void* mx_ = P_mixed;
            for (int row0 = gw; row0 < MROWS; row0 += RB * NGW) {
                float am[RB][6], af[RB][6], sa[RB], sf[RB], sc[RB]; f32x4 oc[RB];
#pragma unroll
                for (int k = 0; k < RB; ++k) { const unsigned row = (unsigned)min(row0 + k * NGW, MROWS - 1); const int tpos = row & (SEQ - 1);
                    sa[k] = 0.f; sf[k] = 0.f;
#pragma unroll
                    for (int j = 0; j < 3; ++j) { const unsigned ua = gld<unsigned>(om_, (row * 384 + j * 128 + 2 * lane) * 2), uf = gld<unsigned>(of_, (row * 384 + j * 128 + 2 * lane) * 2);
                        am[k][2 * j] = bflo(ua); am[k][2 * j + 1] = bfhi(ua); af[k][2 * j] = bflo(uf); af[k][2 * j + 1] = bfhi(uf);
                        sa[k] += am[k][2 * j] * am[k][2 * j] + am[k][2 * j + 1] * am[k][2 * j + 1]; sf[k] += af[k][2 * j] * af[k][2 * j] + af[k][2 * j + 1] * af[k][2 * j + 1]; }
                    const unsigned zo = (row * NIN + 4 * lane) * 2;
                    const u32x2 b0 = gld<u32x2>(zb_, zo + ZC_ZB * 2), c0 = gld<u32x2>(zb_, zo + ZC_ZC * 2), h0 = gld<u32x2>(zb_, zo + ZC_ZH * 2);
                    u32x2 c1 = {0u, 0u}, h1 = {0u, 0u}, c2 = {0u, 0u}, h2 = {0u, 0u};
                    if (tpos >= 1) { c1 = gld<u32x2>(zb_, zo - NIN * 2 + ZC_ZC * 2); h1 = gld<u32x2>(zb_, zo - NIN * 2 + ZC_ZH * 2); }
                    if (tpos >= 2) { c2 = gld<u32x2>(zb_, zo - NIN * 4 + ZC_ZC * 2); h2 = gld<u32x2>(zb_, zo - NIN * 4 + ZC_ZH * 2); }
                    oc[k][0] = bflo(b0.x) * (w0[0] * bflo(c2.x) * bflo(h2.x) + w1[0] * bflo(c1.x) * bflo(h1.x) + w2[0] * bflo(c0.x) * bflo(h0.x));
                    oc[k][1] = bfhi(b0.x) * (w0[1] * bfhi(c2.x) * bfhi(h2.x) + w1[1] * bfhi(c1.x) * bfhi(h1.x) + w2[1] * bfhi(c0.x) * bfhi(h0.x));
                    oc[k][2] = bflo(b0.y) * (w0[2] * bflo(c2.y) * bflo(h2.y) + w1[2] * bflo(c1.y) * bflo(h1.y) + w2[2] * bflo(c0.y) * bflo(h0.y));
                    oc[k][3] = bfhi(b0.y) * (w0[3] * bfhi(c2.y) * bfhi(h2.y) + w1[3] * bfhi(c1.y) * bfhi(h1.y) + w2[3] * bfhi(c0.y) * bfhi(h0.y));
                    sc[k] = (oc[k][0] * oc[k][0] + oc[k][1] * oc[k][1]) + (oc[k][2] * oc[k][2] + oc[k][3] * oc[k][3]); }
#pragma unroll
                for (int o = 1; o < 64; o <<= 1) {
#pragma unroll
                    for (int k = 0; k < RB; ++k) { sa[k] += __shfl_xor(sa[k], o); sf[k] += __shfl_xor(sf[k], o); sc[k] += __shfl_xor(sc[k], o); } }
#pragma unroll
                for (int k = 0; k < RB; ++k) { const unsigned row = (unsigned)min(row0 + k * NGW, MROWS - 1);
                    const float ra = __builtin_amdgcn_rsqf(sa[k] * (1.f / 384.f) + EPS), rf = __builtin_amdgcn_rsqf(sf[k] * (1.f / 384.f) + EPS), rc = __builtin_amdgcn_rsqf(sc[k] * (1.f / 256.f) + EPS);
                    const unsigned mo = row * DM * 2;
#pragma unroll
                    for (int j = 0; j < 3; ++j) { gst<unsigned>(mx_, mo + (j * 128 + 2 * lane) * 2, pk2(am[k][2 * j] * ra, am[k][2 * j + 1] * ra)); gst<unsigned>(mx_, mo + (640 + j * 128 + 2 * lane) * 2, pk2(af[k][2 * j] * rf, af[k][2 * j + 1] * rf)); }
                    gst<u32x2>(mx_, mo + (384 + 4 * lane) * 2, (u32x2){pk2(oc[k][0] * rc, oc[k][1] * rc), pk2(oc[k][2] * rc, oc[k][3] * rc)}); }
            }
        } }
        GSYNC();
        for (int rep = 0; rep < 1 + ((REP_MASK >> 5) & 1); ++rep) { if (rep) GSYNC();
        if (PHASE_MASK & (1 << 5)) { PH_IDS_L
            pg8::Gemm g{P_mixed, P_Wout, MROWS, DM, DM, DM, DM, 256, 0}; pg8::StaticOrder S; S.init(MROWS, DM, G, bid);
            pg8::EpiRes E{P_hbY, P_hbX, P_ss_ffn}; pg8::gemm_phase<pg8::EpiRes, pg8::StaticOrder, true>(lds, lds + XL_OFF, g, S, E);
        } }
        GSYNC();
        for (int rep = 0; rep < 1 + ((REP_MASK >> 6) & 1); ++rep) { if (rep) GSYNC();
          if (PHASE_MASK & (1 << 6)) { PH_IDS_L
            const float* fcw = args.in[17] + (size_t)L * 3 * NUP; const float* fcb = args.in[18] + (size_t)L * NUP;
            const int rem = (130 * (NUP / 256)) % G, c7 = rem ? bid - rem : bid, g7 = rem ? G - rem : G;
            const bool t_first = c7 >= 0 && ((bid >> 3) & 1);
            for (int pass = 0; pass < 2; ++pass) {
                if (c7 >= 0 && (pass == 0) == t_first) { pg8::Gemm g2{P_pb, P_Wple, MROWS, DM, PLE, PLE, PLE, 256, 0}; pg8::StaticOrder S2; S2.init(MROWS, DM, g7, c7);
                    pg8::EpiRowScale E2{P_tb, DM, nullptr, 0, 0.f, 1.f}; pg8::gemm_phase<pg8::EpiRowScale, pg8::StaticOrder, true>(lds, lds + XL_OFF, g2, S2, E2); }
                if (pass == 0) { pg8::Gemm g{P_hbX, P_Wup, 130 * 256, NUP, DM, DM, DM, 254, -2}; pg8::StaticOrder S; S.init(130 * 256, NUP, G, bid);
                    pg8::EpiFfn E{P_act, P_ss_ffn, fcw, fcb}; pg8::gemm_phase<pg8::EpiFfn, pg8::StaticOrder, true>(lds, lds + XL_OFF, g, S, E); }
            }
          }
        }
        GSYNC();
        if (PHASE_MASK & (1 << 7)) { PH_IDS_L
#ifndef NO_G6
            { pg8::Gemm g{P_act, P_Wdown, MROWS, DM, DFF, DFF, DFF, 256, 0}; pg8::StaticOrder S; S.init(MROWS, DM, G, bid);
              pg8::EpiRes E{P_hbX, P_hbX, P_ss_ple}; pg8::gemm_phase<pg8::EpiRes, pg8::StaticOrder, true>(lds, lds + XL_OFF, g, S, E); }
#endif
        }
        GSYNC();
        for (int rep = 0; rep < 1 + ((REP_MASK >> 8) & 1); ++rep) { if (rep) GSYNC();
        if (PHASE_MASK & (1 << 8)) { PH_IDS_L
            pg8::Gemm g{P_hbX, P_Wpg, MROWS, DM, DM, DM, DM, 256, 0}; pg8::StaticOrder S; S.init(MROWS, DM, G, bid);
            pg8::EpiGate E{P_hbX, L == DEPTH - 1 ? P_hbZ : P_hbY, P_ss_next, P_ss_ple, P_tb}; pg8::gemm_phase<pg8::EpiGate, pg8::StaticOrder, true>(lds, lds + XL_OFF, g, S, E);
        } }
        GSYNC();
    }
    { PH_IDS
        const float* fg = args.in[23];
        { constexpr int RB = 4; const void* hz_ = P_hbZ; void* o_ = P_out;
          f32x4 gg[4];
#pragma unroll
          for (int j = 0; j < 2; ++j) { gg[2 * j] = *((const f32x4*)fg + 2 * lane + 128 * j); gg[2 * j + 1] = *((const f32x4*)fg + 2 * lane + 128 * j + 1); }
          for (int m0 = gw; m0 < MROWS; m0 += RB * NGW) { f32x4 v[RB][4]; float sm[RB];
#pragma unroll
            for (int k = 0; k < RB; ++k) { const unsigned m = (unsigned)min(m0 + k * NGW, MROWS - 1); sm[k] = 0.f;
#pragma unroll
                for (int j = 0; j < 2; ++j) { pg8::unpack8(gld<u32x4>(hz_, m * 2048u + (lane + 64 * j) * 16), v[k][2 * j], v[k][2 * j + 1]); sm[k] += pg8::dot8(v[k][2 * j], v[k][2 * j + 1]); } }
#pragma unroll
            for (int o = 1; o < 64; o <<= 1) {
#pragma unroll
                for (int k = 0; k < RB; ++k) sm[k] += __shfl_xor(sm[k], o); }
#pragma unroll
            for (int k = 0; k < RB; ++k) { const unsigned m = (unsigned)min(m0 + k * NGW, MROWS - 1); const float rs = __builtin_amdgcn_rsqf(sm[k] * (1.f / DM) + EPS);
#pragma unroll
                for (int j = 0; j < 2; ++j) { gst<f32x4>(o_, m * 4096u + (2 * lane + 128 * j) * 16, v[k][2 * j] * rs * gg[2 * j]); gst<f32x4>(o_, m * 4096u + (2 * lane + 128 * j + 1) * 16, v[k][2 * j + 1] * rs * gg[2 * j + 1]); } }
          } }
    }
}

extern "C" void kernel_launch(void* const* d_in, const int* in_sizes, int n_in, void* d_out, int out_size, void* d_ws, size_t ws_size, hipStream_t stream) {
    static int grid = 0;
    if (grid == 0) {
        if (n_in != 24 || out_size != MROWS * DM || ws_size < WS_END) { fprintf(stderr, "kernel_launch: unexpected shapes: n_in %d out %d ws %zu (need %zu)\n", n_in, out_size, ws_size, (size_t)WS_END); grid = -1; return; }
        int dev = 0, cus = 0, per_cu = 0;
        if (hipGetDevice(&dev) != hipSuccess || hipDeviceGetAttribute(&cus, hipDeviceAttributeMultiprocessorCount, dev) != hipSuccess) { grid = -1; return; }
        if (hipFuncSetAttribute((const void*)hymba_fwd, hipFuncAttributeMaxDynamicSharedMemorySize, LDS_BYTES) != hipSuccess) { fprintf(stderr, "kernel_launch: hipFuncSetAttribute failed\n"); grid = -1; return; }
        if (hipOccupancyMaxActiveBlocksPerMultiprocessor(&per_cu, (const void*)hymba_fwd, NTHREADS, LDS_BYTES) != hipSuccess || per_cu < 1) { fprintf(stderr, "kernel_launch: occupancy query gives %d\n", per_cu); per_cu = 1; }
        (void)hipGetLastError();
        grid = cus * 1;
    }
    if (grid < 0) return;
    (void)hipMemsetAsync((char*)d_ws + WS_CTL, 0, ZERO_BYTES, stream);
    Args a{};
    for (int i = 0; i < 24; ++i) a.in[i] = (const float*)d_in[i];
    a.out = (float*)d_out; a.ws = (unsigned char*)d_ws;
    for (int j = 0; j < 16; ++j) a.inv_freq[j] = powf(10000.0f, -(float)(2 * j) / 32.0f);
    void* kargs[] = {&a};
    hipError_t e = hipLaunchCooperativeKernel((const void*)hymba_fwd, dim3(grid), dim3(NTHREADS), kargs, LDS_BYTES, stream);
    if (e != hipSuccess) fprintf(stderr, "kernel_launch: cooperative launch failed: %s (grid %d)\n", hipGetErrorString(e), grid);
}
```

```cpp
#include <hip/hip_runtime.h>
#include <hip/hip_cooperative_groups.h>
#include <cstdio>
#include <cstdint>
#include <cmath>
namespace cg = cooperative_groups;

#define LAS __attribute__((address_space(3)))
typedef unsigned short bf16_t;
typedef short bf16x8 __attribute__((ext_vector_type(8)));
typedef short s16x4 __attribute__((ext_vector_type(4)));
typedef float f32x4 __attribute__((ext_vector_type(4)));
typedef float f32x2 __attribute__((ext_vector_type(2)));
typedef float f32x16 __attribute__((ext_vector_type(16)));
typedef unsigned u32x4 __attribute__((ext_vector_type(4)));
typedef unsigned u32x2 __attribute__((ext_vector_type(2)));

#define GAS __attribute__((address_space(1)))
template <class T> __device__ __forceinline__ T gld(const void* base, unsigned byteoff) { return *(const GAS T*)((const GAS char*)base + byteoff); }
template <class T> __device__ __forceinline__ void gst(void* base, unsigned byteoff, T v) { *(GAS T*)((GAS char*)base + byteoff) = v; }
template <class T> __device__ __forceinline__ void gst_nt(void* base, unsigned byteoff, T v) { __builtin_nontemporal_store(v, (GAS T*)((GAS char*)base + byteoff)); }
__device__ __forceinline__ void gatomic_add(float* base, unsigned byteoff, float v) { (void)__hip_atomic_fetch_add((GAS float*)((GAS char*)base + byteoff), v, __ATOMIC_RELAXED, __HIP_MEMORY_SCOPE_AGENT); }

__device__ __forceinline__ float ss_sum(const float* ss, unsigned row, int nslots) {
    if (nslots == 1) return gld<float>(ss, row * 64u);
    f32x4 a = gld<f32x4>(ss, row * 64u);
    if (nslots == 16) { const f32x4 b = gld<f32x4>(ss, row * 64u + 16), c = gld<f32x4>(ss, row * 64u + 32), d = gld<f32x4>(ss, row * 64u + 48); a = (a + b) + (c + d); }
    return (a[0] + a[1]) + (a[2] + a[3]);
}
constexpr int DM = 1024, NBATCH = 8, SEQ = 4096, MROWS = NBATCH * SEQ, DEPTH = 2;
constexpr int NIN_SRC = 2342, NIN = 2560;
constexpr int QW = 576, KVW = 768, DFF = 2816, NUP = 5632, PLE = 256;
constexpr float EPS = 1e-6f;
constexpr float LOG2E = 1.4426950408889634f;
constexpr float C2_MLA = 0.10206207261596577f * LOG2E;
constexpr float C2_FOX = 0.125f * LOG2E;
constexpr int ZC_ZB = 512, ZC_ZC = 768, ZC_ZH = 1024, ZC_FQ = 1280, ZC_FK = 1664, ZC_FV = 2048;

__device__ __forceinline__ unsigned f2bf(float f) { unsigned u = __builtin_bit_cast(unsigned, f); return (u + 0x7fffu + ((u >> 16) & 1u)) >> 16; }
__device__ __forceinline__ unsigned pk2(float lo, float hi) { typedef __bf16 bf2 __attribute__((ext_vector_type(2))); f32x2 v = {lo, hi}; bf2 b = __builtin_convertvector(v, bf2); return __builtin_bit_cast(unsigned, b); }
__device__ __forceinline__ float bflo(unsigned u) { return __builtin_bit_cast(float, u << 16); }
__device__ __forceinline__ float bfhi(unsigned u) { return __builtin_bit_cast(float, u & 0xffff0000u); }
__device__ __forceinline__ float wave_sum(float v) {
#pragma unroll
    for (int o = 1; o < 64; o <<= 1) v += __shfl_xor(v, o);
    return v;
}
__device__ __forceinline__ float sigmoidf_(float x) { return __builtin_amdgcn_rcpf(1.f + __expf(-x)); }

namespace pg8 {
constexpr int BM = 256, BK = 64, HALF = 128, HTB = HALF * BK * 2  , STAGE_BYTES = 8 * HTB, NXCD = 8, WGM = 4;

__host__ __device__ __forceinline__ int lds_byte(int r, int c) { const int st = (r >> 4) * 2 + (c >> 5), rr = r & 15, cc = c & 31, ob = rr * 64 + cc * 2; return st * 1024 + (ob ^ (((ob >> 9) & 1) << 5)); }
__host__ __device__ __forceinline__ void stage_rc(int b, int& R, int& C) { const int st = b / 1024, sb = b % 1024, swz = sb ^ (((sb >> 9) & 1) << 5); R = (st >> 1) * 16 + swz / 64; C = (st & 1) * 32 + (swz % 64) / 2; }
__host__ __device__ __forceinline__ int perm32(int rho) { const int n = rho >> 4, i = rho & 15; return 8 * (i >> 2) + 4 * n + (i & 3); }

struct Unit { int pm, pn; };
struct Gemm { const bf16_t* A; const bf16_t* Bt; int M, N, K, lda, ldb, rstep, roff; };

struct StaticOrder {
    int nM, nN, nwg, G, c;
    __host__ __device__ void init(int M, int N, int G_, int c_) { nM = M / BM; nN = N / BM; nwg = nM * nN; G = G_; c = c_; }
    __host__ __device__ bool next(int i, Unit& u) const {
        const long L = (long)i * G + c; if (L >= nwg) return false;
        int wgid = (int)L; { const int q = nwg / NXCD, r = nwg % NXCD, xcd = wgid % NXCD, off = wgid / NXCD; wgid = (xcd < r ? xcd * (q + 1) : r * (q + 1) + (xcd - r) * q) + off; }
        const int nig = WGM * nN, gid = wgid / nig, fm = gid * WGM, gsz = (nM - fm) < WGM ? (nM - fm) : WGM;
        u.pm = fm + ((wgid % nig) % gsz); u.pn = (wgid % nig) / gsz; return true;
    }
};

__device__ __forceinline__ u32x4 pack8(const f32x4 v0, const f32x4 v1) { u32x4 w; w.x = pk2(v0[0], v0[1]); w.y = pk2(v0[2], v0[3]); w.z = pk2(v1[0], v1[1]); w.w = pk2(v1[2], v1[3]); return w; }
__device__ __forceinline__ float dot8(const f32x4 v0, const f32x4 v1) { return (v0[0] * v0[0] + v0[1] * v0[1]) + (v0[2] * v0[2] + v0[3] * v0[3]) + (v1[0] * v1[0] + v1[1] * v1[1]) + (v1[2] * v1[2] + v1[3] * v1[3]); }
__device__ __forceinline__ void rope8(f32x4& v0, f32x4& v1, const float* cs, unsigned row, int fq) {
    const f32x4 c0 = gld<f32x4>(cs, (row * 32 + 8 * fq) * 4), c1 = gld<f32x4>(cs, (row * 32 + 8 * fq + 4) * 4);
    f32x4 a, b;
    a[0] = v0[0] * c0[0] - v0[1] * c0[1]; a[1] = v0[0] * c0[1] + v0[1] * c0[0];
    a[2] = v0[2] * c0[2] - v0[3] * c0[3]; a[3] = v0[2] * c0[3] + v0[3] * c0[2];
    b[0] = v1[0] * c1[0] - v1[1] * c1[1]; b[1] = v1[0] * c1[1] + v1[1] * c1[0];
    b[2] = v1[2] * c1[2] - v1[3] * c1[3]; b[3] = v1[2] * c1[3] + v1[3] * c1[2];
    v0 = a; v1 = b;
}

struct EpiRowScale {
    static constexpr bool PERM = true, INIT_ACC = false;
    bf16_t* O; int ldc; const float* ss; int nslots; float inv_n, mul;
    __device__ __forceinline__ void operator()(f32x4 (&acc)[2][2][4][2], const Unit& u, int wr, int wc, int fr, int fq, LAS unsigned char* xl) const {
        const int row0 = u.pm * BM + wr * 64 + fr, col0 = u.pn * BM + wc * 32 + 8 * fq;
#pragma unroll
        for (int ai = 0; ai < 2; ++ai)
#pragma unroll
            for (int m = 0; m < 4; ++m) { const int row = row0 + ai * HALF + m * 16;
                const float sc = ss ? __builtin_amdgcn_rsqf(ss_sum(ss, (unsigned)row, nslots) * inv_n + EPS) * mul : mul;
                const unsigned ob = ((unsigned)row * (unsigned)ldc + (unsigned)col0) * 2u;
#pragma unroll
                for (int bj = 0; bj < 2; ++bj) gst<u32x4>(O, ob + bj * HALF * 2, pack8(acc[ai][bj][m][0] * sc, acc[ai][bj][m][1] * sc));
                if (m == 3) asm volatile("" ::: "memory");     }
    }
};

struct EpiZ {
    static constexpr bool PERM = true, INIT_ACC = false;
    bf16_t* z; const float* ss_in; int nslots; float* ss_q; float* ss_kv; float* ffbuf; bf16_t* krope; const float* cs; unsigned* nb;
    __device__ __forceinline__ void operator()(f32x4 (&acc)[2][2][4][2], const Unit& u, int wr, int wc, int fr, int fq, LAS unsigned char* xl) const {
        const int row0 = u.pm * BM + wr * 64 + fr, col0 = u.pn * BM + wc * 32 + 8 * fq; const int pn = u.pn;
        const bool fox_qk = pn >= 5 && pn <= 7;
        float nbm[2] = {0.f, 0.f};
#pragma unroll
        for (int ai = 0; ai < 2; ++ai)
#pragma unroll
            for (int m = 0; m < 4; ++m) { const int row = row0 + ai * HALF + m * 16;
                const float rs = __builtin_amdgcn_rsqf(ss_sum(ss_in, (unsigned)row, nslots) * (1.f / DM) + EPS);
                const unsigned ob = ((unsigned)row * NIN + (unsigned)col0) * 2u; float sq = 0.f;
#pragma unroll
                for (int bj = 0; bj < 2; ++bj) { f32x4 v0 = acc[ai][bj][m][0] * rs, v1 = acc[ai][bj][m][1] * rs;
                    if (pn == 0 || (pn == 1 && bj == 0)) sq += dot8(v0, v1);
                    if (pn == 1 && bj == 1) {
                        if (wc == 0) { rope8(v0, v1, cs, (unsigned)row, fq); gst<u32x4>(krope, ((unsigned)row * 32 + 8 * fq) * 2, pack8(v0, v1)); }
                        if (wc == 1 && fq == 0) { gst<f32x4>(ffbuf, (unsigned)row * 32, v0); gst<f32x4>(ffbuf, (unsigned)row * 32 + 16, v1); }
                    }
                    if (pn == 5 || (pn == 6 && bj == 0)) { v0 = v0 * C2_FOX; v1 = v1 * C2_FOX; }
                    if (fox_qk) { float s = dot8(v0, v1); s += __shfl_xor(s, 16); s += __shfl_xor(s, 32); nbm[bj] = fmaxf(nbm[bj], s); }
                    gst<u32x4>(z, ob + bj * HALF * 2, pack8(v0, v1)); }
                if (pn <= 1) { sq += __shfl_xor(sq, 16); sq += __shfl_xor(sq, 32); if (fq == 0) gst<float>(pn == 0 ? ss_q : ss_kv, ((unsigned)row * 16u + wc) * 4u, sq); }
                if (m == 3) asm volatile("" ::: "memory");
            }
        if (fox_qk) {
#pragma unroll
            for (int bj = 0; bj < 2; ++bj) { float v = nbm[bj];
#pragma unroll
                for (int o = 1; o < 16; o <<= 1) v = fmaxf(v, __shfl_xor(v, o));
                const int g32 = pn * 8 + bj * 4 + wc, isk = g32 >= 52 ? 1 : 0, gl = g32 - (isk ? 52 : 40), bh = (u.pm * BM / SEQ) * 6 + (gl >> 1);
                if (fr == 0 && fq == 0) atomicMax(nb + bh + 128 * isk + 256 * (gl & 1), __float_as_uint(v)); }
        }
    }
};

struct EpiQ {
    static constexpr bool PERM = true, INIT_ACC = false;
    bf16_t* q; const float* ss; const float* cs;
    __device__ __forceinline__ void operator()(f32x4 (&acc)[2][2][4][2], const Unit& u, int wr, int wc, int fr, int fq, LAS unsigned char* xl) const {
        const int row0 = u.pm * BM + wr * 64 + fr;
#pragma unroll
        for (int ai = 0; ai < 2; ++ai)
#pragma unroll
            for (int m = 0; m < 4; ++m) { const int row = row0 + ai * HALF + m * 16;
                const float rs = __builtin_amdgcn_rsqf(ss_sum(ss, (unsigned)row, 4) * (1.f / 256.f) + EPS) * C2_MLA;
#pragma unroll
                for (int bj = 0; bj < 2; ++bj) { const int g = u.pn * BM + bj * HALF + wc * 32;
                    if (g < QW) { f32x4 v0 = acc[ai][bj][m][0] * rs, v1 = acc[ai][bj][m][1] * rs;
                        if (((g >> 5) % 3) == 2) rope8(v0, v1, cs, (unsigned)row, fq);
                        gst<u32x4>(q, ((unsigned)row * QW + g + 8 * fq) * 2, pack8(v0, v1)); } }
                if (m == 3) asm volatile("" ::: "memory");
            }
    }
};

__device__ __forceinline__ void unpack8(const u32x4 w, f32x4& a, f32x4& b) { a[0] = bflo(w.x); a[1] = bfhi(w.x); a[2] = bflo(w.y); a[3] = bfhi(w.y); b[0] = bflo(w.z); b[1] = bfhi(w.z); b[2] = bflo(w.w); b[3] = bfhi(w.w); }
struct EpiRes {
    static constexpr bool PERM = true, INIT_ACC = true;
    const bf16_t* hin; bf16_t* hb; float* ss_out;
    __device__ __forceinline__ void init_acc(f32x4 (&acc)[2][2][4][2], const Unit& u, int wr, int wc, int fr, int fq) const {
        const int row0 = u.pm * BM + wr * 64 + fr, col0 = u.pn * BM + wc * 32 + 8 * fq;
#pragma unroll
        for (int ai = 0; ai < 2; ++ai)
#pragma unroll
            for (int m = 0; m < 4; ++m) { const unsigned off = ((unsigned)(row0 + ai * HALF + m * 16) * DM + (unsigned)col0) * 2u;
#pragma unroll
                for (int bj = 0; bj < 2; ++bj) unpack8(gld<u32x4>(hin, off + bj * HALF * 2), acc[ai][bj][m][0], acc[ai][bj][m][1]); }
    }
    __device__ __forceinline__ void operator()(f32x4 (&acc)[2][2][4][2], const Unit& u, int wr, int wc, int fr, int fq, LAS unsigned char* xl) const {
        const int row0 = u.pm * BM + wr * 64 + fr, col0 = u.pn * BM + wc * 32 + 8 * fq;
#pragma unroll
        for (int ai = 0; ai < 2; ++ai)
#pragma unroll
            for (int m = 0; m < 4; ++m) { const int row = row0 + ai * HALF + m * 16; const unsigned off = ((unsigned)row * DM + (unsigned)col0) * 2u; float sq = 0.f;
#pragma unroll
                for (int bj = 0; bj < 2; ++bj) { const f32x4 v0 = acc[ai][bj][m][0], v1 = acc[ai][bj][m][1];
                    gst<u32x4>(hb, off + bj * HALF * 2, pack8(v0, v1)); sq += dot8(v0, v1); }
                sq += __shfl_xor(sq, 16); sq += __shfl_xor(sq, 32); if (fq == 0) gst<float>(ss_out, ((unsigned)row * 16u + u.pn * 4 + wc) * 4u, sq);
                if (m == 3) asm volatile("" ::: "memory");
            }
    }
};

struct EpiGate {
    static constexpr bool PERM = true, INIT_ACC = false;
    const bf16_t* hin; bf16_t* hb; float* ss_out; const float* ss_in; const bf16_t* t;
    __device__ __forceinline__ void operator()(f32x4 (&acc)[2][2][4][2], const Unit& u, int wr, int wc, int fr, int fq, LAS unsigned char* xl) const {
        const int row0 = u.pm * BM + wr * 64 + fr, col0 = u.pn * BM + wc * 32 + 8 * fq;
#pragma unroll
        for (int ai = 0; ai < 2; ++ai)
#pragma unroll
            for (int m = 0; m < 4; ++m) { const int row = row0 + ai * HALF + m * 16; const unsigned off = ((unsigned)row * DM + (unsigned)col0) * 2u; float sq = 0.f;
                const float rs = __builtin_amdgcn_rsqf(ss_sum(ss_in, (unsigned)row, 16) * (1.f / DM) + EPS);
#pragma unroll
                for (int bj = 0; bj < 2; ++bj) { f32x4 h0, h1, t0, t1; unpack8(gld<u32x4>(hin, off + bj * HALF * 2), h0, h1); unpack8(gld<u32x4>(t, off + bj * HALF * 2), t0, t1);
                    const f32x4 a0 = acc[ai][bj][m][0] * rs, a1 = acc[ai][bj][m][1] * rs;
                    f32x4 v0, v1;
#pragma unroll
                    for (int e = 0; e < 4; ++e) { v0[e] = h0[e] + sigmoidf_(a0[e]) * t0[e]; v1[e] = h1[e] + sigmoidf_(a1[e]) * t1[e]; }
                    gst<u32x4>(hb, off + bj * HALF * 2, pack8(v0, v1)); sq += dot8(v0, v1); }
                sq += __shfl_xor(sq, 16); sq += __shfl_xor(sq, 32); if (fq == 0) gst<float>(ss_out, ((unsigned)row * 16u + u.pn * 4 + wc) * 4u, sq);
                if (m == 3) asm volatile("" ::: "memory");
            }
    }
};

__device__ __forceinline__ float dpp_shr1(float old, float src) { return __int_as_float(__builtin_amdgcn_update_dpp(__float_as_int(old), __float_as_int(src), 0x111, 0xf, 0xf, false)); }
__device__ __forceinline__ float dpp_shr2(float old, float src) { return __int_as_float(__builtin_amdgcn_update_dpp(__float_as_int(old), __float_as_int(src), 0x112, 0xf, 0xf, false)); }
__device__ __forceinline__ float dpp_ror1(float src) { return __int_as_float(__builtin_amdgcn_mov_dpp(__float_as_int(src), 0x121, 0xf, 0xf, true)); }
__device__ __forceinline__ float dpp_ror2(float src) { return __int_as_float(__builtin_amdgcn_mov_dpp(__float_as_int(src), 0x122, 0xf, 0xf, true)); }
struct EpiFfn {
    static constexpr bool PERM = true, INIT_ACC = false;
    bf16_t* act; const float* ss; const float* cw; const float* cb;
    __device__ __forceinline__ void operator()(f32x4 (&acc)[2][2][4][2], const Unit& u, int wr, int wc, int fr, int fq, LAS unsigned char* xl) const {
        LAS unsigned char* Bb = xl;
        const int rbase = u.pm * 254 - 2;
        float rs8[2][4];
#pragma unroll
        for (int ai = 0; ai < 2; ++ai) {
#pragma unroll
            for (int m = 0; m < 4; ++m) { const int rg = rbase + ai * HALF + wr * 64 + m * 16 + fr; const int rgc = rg < 0 ? 0 : (rg >= MROWS ? MROWS - 1 : rg);
                rs8[ai][m] = __builtin_amdgcn_rsqf(ss_sum(ss, (unsigned)rgc, 16) * (1.f / DM) + EPS); }
            asm volatile("" : "+v"(rs8[ai][0]), "+v"(rs8[ai][1]), "+v"(rs8[ai][2]), "+v"(rs8[ai][3]) :: "memory"); }
#pragma unroll
        for (int ai = 0; ai < 2; ++ai)
#pragma unroll
            for (int m = 0; m < 4; ++m) {
#pragma unroll
                for (int bj = 0; bj < 2; ++bj) { acc[ai][bj][m][0] = acc[ai][bj][m][0] * rs8[ai][m]; acc[ai][bj][m][1] = acc[ai][bj][m][1] * rs8[ai][m]; }
                asm volatile("" : "+v"(acc[ai][0][m][0]), "+v"(acc[ai][0][m][1]), "+v"(acc[ai][1][m][0]), "+v"(acc[ai][1][m][1])); }
        if (fr >= 14) {
#pragma unroll
            for (int ai = 0; ai < 2; ++ai)
#pragma unroll
                for (int bj = 0; bj < 2; ++bj) { LAS unsigned char* p = Bb + ((ai * 2 + wr) * 2 + (fr - 14)) * 1024 + (bj * 128 + wc * 32 + fq * 8) * 4;
                    *(LAS f32x4*)p = acc[ai][bj][3][0]; *(LAS f32x4*)(p + 16) = acc[ai][bj][3][1]; }
        }
        asm volatile("s_waitcnt lgkmcnt(0)" ::: "memory"); __builtin_amdgcn_s_barrier(); asm volatile("" ::: "memory");
#pragma unroll
        for (int bj = 0; bj < 2; ++bj) {
            const int ch = bj * DFF + 128 * u.pn + 32 * wc + 8 * fq;
            f32x4 w0[2], w1[2], w2[2], bb[2];
#pragma unroll
            for (int n = 0; n < 2; ++n) { w0[n] = gld<f32x4>(cw, (ch + 4 * n) * 4); w1[n] = gld<f32x4>(cw, (NUP + ch + 4 * n) * 4); w2[n] = gld<f32x4>(cw, (2 * NUP + ch + 4 * n) * 4); bb[n] = gld<f32x4>(cb, (ch + 4 * n) * 4); }
#pragma unroll
            for (int ai = 0; ai < 2; ++ai) {
                f32x4 pg[2];
                pg[0] = (f32x4){0.f, 0.f, 0.f, 0.f}; pg[1] = pg[0];
#pragma unroll
                for (int m = 0; m < 4; ++m) {
                    f32x4 y[2] = {acc[ai][bj][m][0], acc[ai][bj][m][1]}; asm volatile("" : "+v"(y[0]), "+v"(y[1]));
                    f32x4 x1[2], x2[2];
                    if (m == 0) {
                        x1[0] = pg[0]; x1[1] = pg[0]; x2[0] = pg[0]; x2[1] = pg[0];
                        if (wr == 1 || ai == 1) { const int pai = wr == 1 ? ai : 0, pwr = wr == 1 ? 0 : 1;
                            const LAS unsigned char* p = Bb + ((pai * 2 + pwr) * 2) * 1024 + (bj * 128 + wc * 32 + fq * 8) * 4;
                            if (fr < 2) { x2[0] = *(const LAS f32x4*)(p + fr * 1024); x2[1] = *(const LAS f32x4*)(p + fr * 1024 + 16); }
                            if (fr < 1) { x1[0] = *(const LAS f32x4*)(p + 1024); x1[1] = *(const LAS f32x4*)(p + 1024 + 16); } }
                    } else {
#pragma unroll
                        for (int n = 0; n < 2; ++n)
#pragma unroll
                            for (int e = 0; e < 4; ++e) { x1[n][e] = dpp_ror1(pg[n][e]); x2[n][e] = dpp_ror2(pg[n][e]); }
                    }
                    const int rl = ai * HALF + wr * 64 + m * 16 + fr, rg = rbase + rl; const int tpos = rg & (SEQ - 1);
                    const bool bstart = ((rbase + ai * HALF + wr * 64 + m * 16 + 15) & (SEQ - 1)) < 17;
                    f32x4 o[2], p1[2], p2[2];
#pragma unroll
                    for (int n = 0; n < 2; ++n)
#pragma unroll
                        for (int e = 0; e < 4; ++e) { p1[n][e] = dpp_shr1(x1[n][e], y[n][e]); p2[n][e] = dpp_shr2(x2[n][e], y[n][e]); }
                    if (__builtin_expect(bstart, 0)) {
                        asm volatile("" : "+v"(p1[0]), "+v"(p1[1]), "+v"(p2[0]), "+v"(p2[1]));
                        if (tpos < 1) { p1[0] = (f32x4){0.f, 0.f, 0.f, 0.f}; p1[1] = p1[0]; }
                        if (tpos < 2) { p2[0] = (f32x4){0.f, 0.f, 0.f, 0.f}; p2[1] = p2[0]; } }
#pragma unroll
                    for (int n = 0; n < 2; ++n) o[n] = w0[n] * p2[n] + w1[n] * p1[n] + w2[n] * y[n] + bb[n];
                    pg[0] = y[0]; pg[1] = y[1];
                    if (bj == 0) {
#pragma unroll
                        for (int e = 0; e < 4; ++e) { o[0][e] = o[0][e] * sigmoidf_(o[0][e]); o[1][e] = o[1][e] * sigmoidf_(o[1][e]); }
                        asm volatile("" : "+v"(o[0]), "+v"(o[1]));
                        acc[ai][0][m][0] = o[0]; acc[ai][0][m][1] = o[1];
                    } else {
                        if (rl >= 2 && rg < MROWS) gst<u32x4>(act, ((unsigned)rg * DFF + 128 * u.pn + 32 * wc + 8 * fq) * 2u, pack8(acc[ai][0][m][0] * o[0], acc[ai][0][m][1] * o[1]));
                    }
                    __builtin_amdgcn_sched_barrier(0);
                }
            }
            asm volatile("" ::: "memory");
        }
    }
};

template <class Epi, class Sched, bool ALIGN_EPI>
__device__ __forceinline__ void gemm_phase(LAS unsigned char* lds, LAS unsigned char* xlds, const Gemm g, const Sched& S, const Epi& E) {
    int tid_o = threadIdx.x; asm volatile("" : "+v"(tid_o));
    const int tid = tid_o, wid = __builtin_amdgcn_readfirstlane(tid >> 6), lane = tid & 63, wr = wid >> 2, wc = wid & 3, fr = lane & 15, fq = lane >> 4;
    int K_o = g.K; asm volatile("" : "+s"(K_o));
    const int K = K_o, nt = K / BK;
    unsigned voffA[2], voffB[2];
#pragma unroll
    for (int i = 0; i < 2; ++i) { int R, C; stage_rc(tid * 16 + i * 8192, R, C); const int Rb = Epi::PERM ? ((R & ~31) + perm32(R & 31)) : R;
        voffA[i] = (unsigned)(R * g.lda + C) * 2u; voffB[i] = (unsigned)(Rb * g.ldb + C) * 2u; }
    const size_t kstep = (size_t)(BK * 2);
    const size_t hA = (size_t)HALF * g.lda * 2, hB = (size_t)HALF * g.ldb * 2;
    const size_t tB = 2 * hB; const long rowA = (long)g.lda * 2;
    const unsigned ldsw = (unsigned)wid * 1024u;
    const int aoff = lds_byte(wr * 64 + fr, fq * 8), boff = lds_byte(wc * 32 + fr, fq * 8);
#define PG8_SA(b, h) (((b) * 2 + (h)) * HTB)
#define PG8_SB(b, h) ((4 + (b) * 2 + (h)) * HTB)
#define PG8_STAGE(bufoff, gbase, voff) do { _Pragma("unroll") for (int _i = 0; _i < 2; ++_i) \
        __builtin_amdgcn_global_load_lds((const unsigned*)((const char*)(gbase) + (voff)[_i]), (LAS unsigned*)(lds + (bufoff) + ldsw + _i * 8192), 16, 0, 0); } while (0)
#define PG8_LDA(dst, b, h) do { _Pragma("unroll") for (int m = 0; m < 4; ++m) _Pragma("unroll") for (int k = 0; k < 2; ++k) dst[m][k] = *(const LAS bf16x8*)(lds + PG8_SA(b, h) + aoff + m * 2048 + k * 1024); } while (0)
#define PG8_LDB(dst, b, h) do { _Pragma("unroll") for (int n = 0; n < 2; ++n) _Pragma("unroll") for (int k = 0; k < 2; ++k) dst[n][k] = *(const LAS bf16x8*)(lds + PG8_SB(b, h) + boff + n * 2048 + k * 1024); } while (0)
#define PG8_MMA(ai, bj, At, Bt) do { __builtin_amdgcn_s_setprio(1); _Pragma("unroll") for (int m = 0; m < 4; ++m) _Pragma("unroll") for (int n = 0; n < 2; ++n) _Pragma("unroll") for (int k = 0; k < 2; ++k) \
        acc[ai][bj][m][n] = __builtin_amdgcn_mfma_f32_16x16x32_bf16(Bt[n][k], At[m][k], acc[ai][bj][m][n], 0, 0, 0); __builtin_amdgcn_s_setprio(0); } while (0)
#define PG8_WAIT_V(n) asm volatile("s_waitcnt vmcnt(" #n ")" ::: "memory")
#define PG8_WAIT_L(n) asm volatile("s_waitcnt lgkmcnt(" #n ")" ::: "memory")
#define PG8_BAR __builtin_amdgcn_s_barrier()
#define PG8_SCHED __builtin_amdgcn_sched_barrier(0)
    Unit cur, nxt; int ui = 0;
    if (!S.next(0, cur)) return;
    f32x4 acc[2][2][4][2];
    if constexpr (Epi::INIT_ACC) E.init_acc(acc, cur, wr, wc, fr, fq);
    else {
#pragma unroll
    for (int a = 0; a < 2; ++a)
#pragma unroll
        for (int b = 0; b < 2; ++b)
#pragma unroll
            for (int m = 0; m < 4; ++m)
#pragma unroll
                for (int n = 0; n < 2; ++n) acc[a][b][m][n] = (f32x4){0.f, 0.f, 0.f, 0.f};
    }
    bf16x8 At[4][2], B0[2][2], B1[2][2];
    const char* cA = (const char*)g.A + ((long)cur.pm * g.rstep + g.roff) * rowA; const char* cB = (const char*)g.Bt + (size_t)cur.pn * tB;
    PG8_STAGE(PG8_SB(0, 0), cB, voffB); PG8_STAGE(PG8_SB(0, 1), cB + hB, voffB); PG8_STAGE(PG8_SA(0, 0), cA, voffA); PG8_STAGE(PG8_SA(0, 1), cA + hA, voffA);
    if (wr == 1) PG8_BAR;
    PG8_WAIT_V(2); PG8_BAR;
    PG8_STAGE(PG8_SB(1, 0), cB + kstep, voffB); PG8_STAGE(PG8_SA(1, 0), cA + kstep, voffA); PG8_STAGE(PG8_SB(1, 1), cB + hB + kstep, voffB);
    PG8_WAIT_V(6); PG8_BAR;
    for (;;) {
        const bool has_next = S.next(ui + 1, nxt);
        const char* nA = has_next ? (const char*)g.A + ((long)nxt.pm * g.rstep + g.roff) * rowA : cA; const char* nB = has_next ? (const char*)g.Bt + (size_t)nxt.pn * tB : cB;
        for (int t = 0; t < nt; t += 2) {
            const bool last = (t == nt - 2);
            const char* a1 = cA + (size_t)(t + 1) * kstep;
            const char* a2 = last ? nA : cA + (size_t)(t + 2) * kstep; const char* b2 = last ? nB : cB + (size_t)(t + 2) * kstep;
            const char* a3 = a2 + kstep; const char* b3 = b2 + kstep;
            PG8_LDB(B0, 0, 0); PG8_LDB(B1, 0, 1); PG8_SCHED; PG8_LDA(At, 0, 0); PG8_STAGE(PG8_SA(1, 1), a1 + hA, voffA);
            PG8_WAIT_V(8); PG8_WAIT_L(0); PG8_BAR; PG8_MMA(0, 0, At, B0); PG8_MMA(0, 1, At, B1); PG8_BAR; PG8_SCHED;
            PG8_LDA(At, 0, 1); PG8_STAGE(PG8_SB(0, 0), b2, voffB); PG8_STAGE(PG8_SB(0, 1), b2 + hB, voffB); PG8_STAGE(PG8_SA(0, 0), a2, voffA);
            PG8_WAIT_V(8); PG8_WAIT_L(0); PG8_BAR; PG8_MMA(1, 0, At, B0); PG8_MMA(1, 1, At, B1); PG8_BAR; PG8_SCHED;
            PG8_LDB(B0, 1, 0); PG8_LDB(B1, 1, 1); PG8_SCHED; PG8_LDA(At, 1, 0); PG8_STAGE(PG8_SA(0, 1), a2 + hA, voffA);
            PG8_WAIT_V(8); PG8_WAIT_L(0); PG8_BAR; PG8_MMA(0, 0, At, B0); PG8_MMA(0, 1, At, B1); PG8_BAR; PG8_SCHED;
            PG8_LDA(At, 1, 1); PG8_STAGE(PG8_SB(1, 0), b3, voffB); PG8_STAGE(PG8_SB(1, 1), b3 + hB, voffB); PG8_STAGE(PG8_SA(1, 0), a3, voffA);
            PG8_WAIT_V(8); PG8_WAIT_L(0); PG8_BAR; PG8_MMA(1, 0, At, B0); PG8_MMA(1, 1, At, B1); PG8_BAR; PG8_SCHED;
        }
        if constexpr (ALIGN_EPI) { if (wr == 0) PG8_BAR; }
        E(acc, cur, wr, wc, fr, fq, xlds);
        if (!has_next) break;
        if constexpr (Epi::INIT_ACC) E.init_acc(acc, nxt, wr, wc, fr, fq);
        else {
#pragma unroll
        for (int a = 0; a < 2; ++a)
#pragma unroll
            for (int b = 0; b < 2; ++b)
#pragma unroll
                for (int m = 0; m < 4; ++m)
#pragma unroll
                    for (int n = 0; n < 2; ++n) acc[a][b][m][n] = (f32x4){0.f, 0.f, 0.f, 0.f};
        }
        cur = nxt; cA = nA; cB = nB; ++ui;
        if constexpr (ALIGN_EPI) { if (wr == 1) PG8_BAR; }
    }
    PG8_WAIT_V(0);
    if constexpr (!ALIGN_EPI) { if (wr == 0) PG8_BAR; }
    PG8_BAR;
#undef PG8_SA
#undef PG8_SB
#undef PG8_STAGE
#undef PG8_LDA
#undef PG8_LDB
#undef PG8_MMA
#undef PG8_WAIT_V
#undef PG8_WAIT_L
#undef PG8_BAR
#undef PG8_SCHED
}
}

namespace att {
constexpr int KBUF = 12288, VBUF = 8192;
constexpr int OFF_K = 0, OFF_V = 4 * KBUF, OFF_C = 4 * KBUF + 4 * VBUF, OFF_U = OFF_C + 1024, ATT_LDS = OFF_U + 64;
__device__ __forceinline__ int crow(int r, int hi) { return (r & 3) + 8 * (r >> 2) + 4 * hi; }
__device__ __forceinline__ s16x4 vtr(const LAS char* p) { typedef short v4i16_t __attribute__((ext_vector_type(4))); return __builtin_bit_cast(s16x4, __builtin_amdgcn_ds_read_tr16_b64_v4i16((LAS v4i16_t*)p)); }
__device__ __forceinline__ float xmax32(float m) { auto rr = __builtin_amdgcn_permlane32_swap(__float_as_uint(m), __float_as_uint(m), false, false); return fmaxf(__uint_as_float(rr[0]), __uint_as_float(rr[1])); }
__device__ __forceinline__ float xsum32(float m) { auto rr = __builtin_amdgcn_permlane32_swap(__float_as_uint(m), __float_as_uint(m), false, false); return __uint_as_float(rr[0]) + __uint_as_float(rr[1]); }
__device__ __forceinline__ void lbar() { asm volatile("s_waitcnt lgkmcnt(0)" ::: "memory"); __builtin_amdgcn_s_barrier(); asm volatile("" ::: "memory"); }

struct Bundle { u32x4 k, v, r; float c; };

template <bool MLA> struct Ctx {
    LAS char* shm; const void *Kn, *Kr, *V, *cum; unsigned kofs, vofs, rofs, cofs, kstep, vstep; int kdst, vdst, rdst, tid;
    __device__ __forceinline__ void load(Bundle& b, int kt, int vt) const {
        b.k = gld<u32x4>(Kn, kofs + (unsigned)kt * kstep); b.v = gld<u32x4>(V, vofs + (unsigned)vt * vstep);
        if (MLA) { if (tid < 256) b.r = gld<u32x4>(Kr, rofs + (unsigned)kt * 4096u); } else { if (tid < 64) b.c = -gld<float>(cum, cofs + (unsigned)kt * 256u); }
    }
    __device__ __forceinline__ void store_k(const Bundle& b, int bi) const {
        *(LAS u32x4*)(shm + OFF_K + bi * KBUF + kdst) = b.k;
        if (MLA) { if (tid < 256) *(LAS u32x4*)(shm + OFF_K + bi * KBUF + rdst) = b.r; } else { if (tid < 64) *(LAS float*)(shm + OFF_C + bi * 256 + tid * 4) = b.c; }
    }
    __device__ __forceinline__ void store(const Bundle& b, int bi) const { store_k(b, bi); *(LAS u32x4*)(shm + OFF_V + bi * VBUF + vdst) = b.v; }
};

template <bool MLA, int NC>
__device__ __forceinline__ void qk_tile(f32x16& s0, f32x16& s1, const LAS char* shm, int bi, const bf16x8 (&qf)[NC], int r, int h) {
    const LAS char* kb = shm + OFF_K + bi * KBUF + h * 1024 + r * 16;
    if (MLA) {
#pragma unroll
        for (int i = 0; i < 16; ++i) { s0[i] = 0.f; s1[i] = 0.f; }
    } else { const LAS float* cb = (const LAS float*)(shm + OFF_C + bi * 256);
#pragma unroll
        for (int g = 0; g < 4; ++g) { const f32x4 c0 = *(const LAS f32x4*)(cb + 8 * g + 4 * h), c1 = *(const LAS f32x4*)(cb + 32 + 8 * g + 4 * h);
#pragma unroll
            for (int e = 0; e < 4; ++e) { s0[4 * g + e] = c0[e]; s1[4 * g + e] = c1[e]; } } }
#pragma unroll
    for (int c = 0; c < NC; ++c) { const bf16x8 a0 = *(const LAS bf16x8*)(kb + c * 2048), a1 = *(const LAS bf16x8*)(kb + c * 2048 + 512);
        s0 = __builtin_amdgcn_mfma_f32_32x32x16_bf16(a0, qf[c], s0, 0, 0, 0); s1 = __builtin_amdgcn_mfma_f32_32x32x16_bf16(a1, qf[c], s1, 0, 0, 0); }
}

__device__ __forceinline__ void softmax_pv(f32x16& s0, f32x16& s1, f32x16& o0, f32x16& o1, float& mrun, float& lrun, const LAS char* shm, int bi, int kv0, int qrow, bool band, int lane, int h) {
    if (band) {
#pragma unroll
        for (int i = 0; i < 16; ++i) { const int kv = kv0 + crow(i, h); if (kv > qrow) s0[i] = -INFINITY; if (kv + 32 > qrow) s1[i] = -INFINITY; }
    }
    float mx = fmaxf(fmaxf(s0[0], s1[0]), fmaxf(s0[1], s1[1]));
#pragma unroll
    for (int i = 2; i < 16; i += 2) mx = fmaxf(fmaxf(mx, s0[i]), fmaxf(fmaxf(s1[i], s0[i + 1]), s1[i + 1]));
    mx = xmax32(mx);
    const float mnew = fmaxf(mrun, mx), alpha = __builtin_amdgcn_exp2f(mrun - mnew); mrun = mnew;
    float ps0 = 0.f, ps1 = 0.f;
#pragma unroll
    for (int i = 0; i < 16; ++i) { s0[i] = __builtin_amdgcn_exp2f(s0[i] - mnew); s1[i] = __builtin_amdgcn_exp2f(s1[i] - mnew); ps0 += s0[i]; ps1 += s1[i]; }
    lrun = lrun * alpha + (ps0 + ps1);
#pragma unroll
    for (int i = 0; i < 16; ++i) { o0[i] *= alpha; o1[i] *= alpha; }
    u32x4 pw[4];
#pragma unroll
    for (int s = 0; s < 2; ++s) {
        pw[s] = (u32x4){pk2(s0[8 * s], s0[8 * s + 1]), pk2(s0[8 * s + 2], s0[8 * s + 3]), pk2(s0[8 * s + 4], s0[8 * s + 5]), pk2(s0[8 * s + 6], s0[8 * s + 7])};
        pw[2 + s] = (u32x4){pk2(s1[8 * s], s1[8 * s + 1]), pk2(s1[8 * s + 2], s1[8 * s + 3]), pk2(s1[8 * s + 4], s1[8 * s + 5]), pk2(s1[8 * s + 6], s1[8 * s + 7])}; }
    const LAS char* vb = shm + OFF_V + bi * VBUF + ((lane >> 4) & 1) * 32 + (lane & 3) * 8 + (4 * h + ((lane & 15) >> 2)) * 64;
#pragma unroll
    for (int ks = 0; ks < 4; ++ks) {
        const s16x4 l0 = vtr(vb + ks * 1024), h0 = vtr(vb + ks * 1024 + 512), l1 = vtr(vb + 4096 + ks * 1024), h1 = vtr(vb + 4096 + ks * 1024 + 512);
        const bf16x8 va0 = __builtin_shufflevector(l0, h0, 0, 1, 2, 3, 4, 5, 6, 7), va1 = __builtin_shufflevector(l1, h1, 0, 1, 2, 3, 4, 5, 6, 7);
        const bf16x8 pb = __builtin_bit_cast(bf16x8, pw[ks]);
        o0 = __builtin_amdgcn_mfma_f32_32x32x16_bf16(va0, pb, o0, 0, 0, 0);
        o1 = __builtin_amdgcn_mfma_f32_32x32x16_bf16(va1, pb, o1, 0, 0, 0);
    }
}

__device__ __forceinline__ void softmax_pv2(f32x16& a0, f32x16& a1, f32x16& b0, f32x16& b1, f32x16& o0, f32x16& o1, float& mrun, float& lrun, const LAS char* shm, int sa, int sb, int lane, int h) {
    float mx = fmaxf(fmaxf(a0[0], a1[0]), fmaxf(b0[0], b1[0]));
#pragma unroll
    for (int i = 1; i < 16; ++i) mx = fmaxf(fmaxf(mx, a0[i]), fmaxf(fmaxf(a1[i], b0[i]), b1[i]));
    mx = xmax32(mx);
    const float mnew = fmaxf(mrun, mx), alpha = __builtin_amdgcn_exp2f(mrun - mnew); mrun = mnew;
    float ps0 = 0.f, ps1 = 0.f, ps2 = 0.f, ps3 = 0.f;
#pragma unroll
    for (int i = 0; i < 16; ++i) { a0[i] = __builtin_amdgcn_exp2f(a0[i] - mnew); a1[i] = __builtin_amdgcn_exp2f(a1[i] - mnew); b0[i] = __builtin_amdgcn_exp2f(b0[i] - mnew); b1[i] = __builtin_amdgcn_exp2f(b1[i] - mnew);
        ps0 += a0[i]; ps1 += a1[i]; ps2 += b0[i]; ps3 += b1[i]; }
    lrun = lrun * alpha + ((ps0 + ps1) + (ps2 + ps3));
#pragma unroll
    for (int i = 0; i < 16; ++i) { o0[i] *= alpha; o1[i] *= alpha; }
    const int vlane = ((lane >> 4) & 1) * 32 + (lane & 3) * 8 + (4 * h + ((lane & 15) >> 2)) * 64;
#pragma unroll
    for (int sub = 0; sub < 2; ++sub) {
        const f32x16& s0 = sub ? b0 : a0; const f32x16& s1 = sub ? b1 : a1;
        u32x4 pw[4];
#pragma unroll
        for (int s = 0; s < 2; ++s) {
            pw[s] = (u32x4){pk2(s0[8 * s], s0[8 * s + 1]), pk2(s0[8 * s + 2], s0[8 * s + 3]), pk2(s0[8 * s + 4], s0[8 * s + 5]), pk2(s0[8 * s + 6], s0[8 * s + 7])};
            pw[2 + s] = (u32x4){pk2(s1[8 * s], s1[8 * s + 1]), pk2(s1[8 * s + 2], s1[8 * s + 3]), pk2(s1[8 * s + 4], s1[8 * s + 5]), pk2(s1[8 * s + 6], s1[8 * s + 7])}; }
        const LAS char* vb = shm + OFF_V + (sub ? sb : sa) * VBUF + vlane;
#pragma unroll
        for (int ks = 0; ks < 4; ++ks) {
            const s16x4 l0 = vtr(vb + ks * 1024), h0 = vtr(vb + ks * 1024 + 512), l1 = vtr(vb + 4096 + ks * 1024), h1 = vtr(vb + 4096 + ks * 1024 + 512);
            const bf16x8 va0 = __builtin_shufflevector(l0, h0, 0, 1, 2, 3, 4, 5, 6, 7), va1 = __builtin_shufflevector(l1, h1, 0, 1, 2, 3, 4, 5, 6, 7);
            const bf16x8 pb = __builtin_bit_cast(bf16x8, pw[ks]);
            o0 = __builtin_amdgcn_mfma_f32_32x32x16_bf16(va0, pb, o0, 0, 0, 0);
            o1 = __builtin_amdgcn_mfma_f32_32x32x16_bf16(va1, pb, o1, 0, 0, 0);
        }
    }
}
template <int NC>
__device__ __forceinline__ void qk_tile_ref(f32x16& s0, f32x16& s1, const f32x16& negm, const LAS char* shm, int bi, const bf16x8 (&qf)[NC], int r, int h) {
    const LAS char* kb = shm + OFF_K + bi * KBUF + h * 1024 + r * 16;
    { const bf16x8 a0 = *(const LAS bf16x8*)(kb), a1 = *(const LAS bf16x8*)(kb + 512);
      s0 = __builtin_amdgcn_mfma_f32_32x32x16_bf16(a0, qf[0], negm, 0, 0, 0); s1 = __builtin_amdgcn_mfma_f32_32x32x16_bf16(a1, qf[0], negm, 0, 0, 0); }
#pragma unroll
    for (int c = 1; c < NC; ++c) { const bf16x8 a0 = *(const LAS bf16x8*)(kb + c * 2048), a1 = *(const LAS bf16x8*)(kb + c * 2048 + 512);
        s0 = __builtin_amdgcn_mfma_f32_32x32x16_bf16(a0, qf[c], s0, 0, 0, 0); s1 = __builtin_amdgcn_mfma_f32_32x32x16_bf16(a1, qf[c], s1, 0, 0, 0); }
}
__device__ __forceinline__ void softmax_pv2_def(f32x16& a0, f32x16& a1, f32x16& b0, f32x16& b1, f32x16& o0, f32x16& o1, f32x16& negm, float& mrun, float& lrun, const LAS char* shm, int sa, int sb, int lane, int h) {
    float mx = fmaxf(fmaxf(a0[0], a1[0]), fmaxf(b0[0], b1[0]));
#pragma unroll
    for (int i = 1; i < 16; ++i) mx = fmaxf(fmaxf(mx, a0[i]), fmaxf(fmaxf(a1[i], b0[i]), b1[i]));
    mx = xmax32(mx);
    if (__any(mx > 8.f)) {
        const float dl = fmaxf(mx, 0.f), alpha = __builtin_amdgcn_exp2f(-dl); mrun += dl; lrun *= alpha;
#pragma unroll
        for (int i = 0; i < 16; ++i) { a0[i] -= dl; a1[i] -= dl; b0[i] -= dl; b1[i] -= dl; o0[i] *= alpha; o1[i] *= alpha; negm[i] = -mrun; }
    }
    float ps0 = 0.f, ps1 = 0.f, ps2 = 0.f, ps3 = 0.f;
#pragma unroll
    for (int i = 0; i < 16; ++i) { a0[i] = __builtin_amdgcn_exp2f(a0[i]); a1[i] = __builtin_amdgcn_exp2f(a1[i]); b0[i] = __builtin_amdgcn_exp2f(b0[i]); b1[i] = __builtin_amdgcn_exp2f(b1[i]);
        ps0 += a0[i]; ps1 += a1[i]; ps2 += b0[i]; ps3 += b1[i]; }
    lrun += (ps0 + ps1) + (ps2 + ps3);
    const int vlane = ((lane >> 4) & 1) * 32 + (lane & 3) * 8 + (4 * h + ((lane & 15) >> 2)) * 64;
#pragma unroll
    for (int sub = 0; sub < 2; ++sub) {
        const f32x16& s0 = sub ? b0 : a0; const f32x16& s1 = sub ? b1 : a1;
        u32x4 pw[4];
#pragma unroll
        for (int s = 0; s < 2; ++s) {
            pw[s] = (u32x4){pk2(s0[8 * s], s0[8 * s + 1]), pk2(s0[8 * s + 2], s0[8 * s + 3]), pk2(s0[8 * s + 4], s0[8 * s + 5]), pk2(s0[8 * s + 6], s0[8 * s + 7])};
            pw[2 + s] = (u32x4){pk2(s1[8 * s], s1[8 * s + 1]), pk2(s1[8 * s + 2], s1[8 * s + 3]), pk2(s1[8 * s + 4], s1[8 * s + 5]), pk2(s1[8 * s + 6], s1[8 * s + 7])}; }
        const LAS char* vb = shm + OFF_V + (sub ? sb : sa) * VBUF + vlane;
#pragma unroll
        for (int ks = 0; ks < 4; ++ks) {
            const s16x4 l0 = vtr(vb + ks * 1024), h0 = vtr(vb + ks * 1024 + 512), l1 = vtr(vb + 4096 + ks * 1024), h1 = vtr(vb + 4096 + ks * 1024 + 512);
            const bf16x8 va0 = __builtin_shufflevector(l0, h0, 0, 1, 2, 3, 4, 5, 6, 7), va1 = __builtin_shufflevector(l1, h1, 0, 1, 2, 3, 4, 5, 6, 7);
            const bf16x8 pb = __builtin_bit_cast(bf16x8, pw[ks]);
            o0 = __builtin_amdgcn_mfma_f32_32x32x16_bf16(va0, pb, o0, 0, 0, 0);
            o1 = __builtin_amdgcn_mfma_f32_32x32x16_bf16(va1, pb, o1, 0, 0, 0);
        }
    }
}
__device__ __forceinline__ void mask_tile(f32x16& s0, f32x16& s1, int kv0, int qrow, int h) {
#pragma unroll
    for (int i = 0; i < 16; ++i) { const int kv = kv0 + crow(i, h); if (kv > qrow) s0[i] = -INFINITY; if (kv + 32 > qrow) s1[i] = -INFINITY; }
}

template <bool MLA>
__device__ __forceinline__ void attn_unit(LAS char* shm, int b, int hd, int qb,
        const bf16_t* Q, int pq, int qoff, const bf16_t* Kn, int pk, int koff, const bf16_t* Kr,
        const bf16_t* V, int pv, int voff, const float* cum, bf16_t* O, int po, int ooff, int T0) {
    constexpr int NC = MLA ? 6 : 4;
    int tid_o = threadIdx.x; asm volatile("" : "+v"(tid_o));
    const int tid = tid_o, lane = tid & 63, r = lane & 31, h = lane >> 5; const int wid = __builtin_amdgcn_readfirstlane(tid >> 6);
    const unsigned rowbase = (unsigned)b * SEQ; const int q0 = qb * 256; const int NT2 = (q0 + 256) / 128;
    const int lkey = tid >> 3, lch = tid & 7;
    Ctx<MLA> C;
    C.shm = shm; C.Kn = Kn; C.Kr = Kr; C.V = V; C.cum = cum; C.tid = tid;
    C.kofs = ((rowbase + lkey) * (unsigned)pk + koff + lch * 8) * 2u; C.kstep = 64u * (unsigned)pk * 2u;
    C.vofs = ((rowbase + lkey) * (unsigned)pv + voff + lch * 8) * 2u; C.vstep = 64u * (unsigned)pv * 2u;
    C.rofs = ((rowbase + (tid >> 2)) * 32u + (tid & 3) * 8) * 2u;
    C.cofs = ((unsigned)(b * 6 + hd) * SEQ + (tid & 63)) * 4u;
    C.kdst = lch * 1024 + lkey * 16;
    C.vdst = (lch >> 2) * 4096 + (lkey >> 4) * 1024 + ((lkey >> 3) & 1) * 512 + (lkey & 7) * 64 + (lch & 3) * 16;
    C.rdst = (8 + (tid & 3)) * 1024 + (tid >> 2) * 16;
    const int qrow = q0 + wid * 32 + r, qlast = q0 + wid * 32 + 31, qfirst = q0 + wid * 32;
    bf16x8 qf[NC];
    { const unsigned qo = ((rowbase + qrow) * (unsigned)pq + qoff + 8 * h) * 2u;
#pragma unroll
      for (int c = 0; c < NC; ++c) qf[c] = gld<bf16x8>(Q, qo + 32 * c); }
    f32x16 o0, o1, sA0, sA1, sB0, sB1, negm;
#pragma unroll
    for (int i = 0; i < 16; ++i) { o0[i] = 0.f; o1[i] = 0.f; negm[i] = 0.f; }
    float mrun = -INFINITY, lrun = 0.f;
    Bundle bA, bB; bA.r = (u32x4){0u, 0u, 0u, 0u}; bB.r = bA.r; bA.c = 0.f; bB.c = 0.f;
    C.load(bA, 2 * T0, 2 * T0); C.load(bB, 2 * T0 + 1, 2 * T0 + 1);
    C.store(bA, 2 * (T0 & 1)); C.store(bB, 2 * (T0 & 1) + 1);
    lbar();
#define ATT_ITER(T_, MODE) do { const int T = (T_); const int sa = 2 * (T & 1), sb = sa + 1, t0 = 2 * T; \
        if (T + 1 < NT2) { C.load(bA, t0 + 2, t0 + 2); C.load(bB, t0 + 3, t0 + 3); } \
        if (MODE == 0) { \
            qk_tile<MLA, NC>(sA0, sA1, shm, sa, qf, r, h); qk_tile<MLA, NC>(sB0, sB1, shm, sb, qf, r, h); \
            softmax_pv2(sA0, sA1, sB0, sB1, o0, o1, mrun, lrun, shm, sa, sb, lane, h); \
        } else if (MODE == 1) { \
            qk_tile_ref<NC>(sA0, sA1, negm, shm, sa, qf, r, h); qk_tile_ref<NC>(sB0, sB1, negm, shm, sb, qf, r, h); \
            softmax_pv2_def(sA0, sA1, sB0, sB1, o0, o1, negm, mrun, lrun, shm, sa, sb, lane, h); \
        } else if (64 * t0 <= qlast) { \
            qk_tile<MLA, NC>(sA0, sA1, shm, sa, qf, r, h); \
            if (64 * t0 + 63 > qfirst) mask_tile(sA0, sA1, 64 * t0, qrow, h); \
            if (64 * (t0 + 1) <= qlast) { qk_tile<MLA, NC>(sB0, sB1, shm, sb, qf, r, h); if (64 * (t0 + 1) + 63 > qfirst) mask_tile(sB0, sB1, 64 * (t0 + 1), qrow, h); } \
            else { _Pragma("unroll") for (int i = 0; i < 16; ++i) { sB0[i] = -INFINITY; sB1[i] = -INFINITY; } } \
            softmax_pv2(sA0, sA1, sB0, sB1, o0, o1, mrun, lrun, shm, sa, sb, lane, h); \
        } \
        if (T + 1 < NT2) { C.store(bA, sa ^ 2); C.store(bB, sb ^ 2); } \
        lbar(); } while (0)
    int Tc = T0;
    if (Tc < NT2 - 2) { ATT_ITER(Tc, 0); ++Tc;
        if (MLA) {
#pragma unroll
            for (int i = 0; i < 16; ++i) negm[i] = -mrun; } }
    for (; Tc < NT2 - 2; ++Tc) ATT_ITER(Tc, (MLA ? 1 : 0));
    for (; Tc < NT2; ++Tc) ATT_ITER(Tc, 2);
#undef ATT_ITER
    lrun = xsum32(lrun);
    const float inv = 1.f / lrun;
    const unsigned oo = ((rowbase + qrow) * (unsigned)po + ooff + 4 * h) * 2u;
#pragma unroll
    for (int g = 0; g < 4; ++g) {
        u32x2 w0 = {pk2(o0[4 * g] * inv, o0[4 * g + 1] * inv), pk2(o0[4 * g + 2] * inv, o0[4 * g + 3] * inv)};
        u32x2 w1 = {pk2(o1[4 * g] * inv, o1[4 * g + 1] * inv), pk2(o1[4 * g + 2] * inv, o1[4 * g + 3] * inv)};
        gst<u32x2>(O, oo + 16 * g, w0); gst<u32x2>(O, oo + 64 + 16 * g, w1); }
}
}

#ifndef REP_MASK
#define REP_MASK 0
#endif
#ifndef PHASE_MASK
#define PHASE_MASK 0xfff
#endif
constexpr int NWAVES = 8, NTHREADS = 512;
constexpr size_t MiB = 1u << 20;
constexpr size_t WS_CTL = 0;
constexpr size_t ZERO_BYTES = 64 * 1024;
constexpr size_t WS_CS = 2 * MiB;
constexpr size_t WS_CUM = 6 * MiB;
constexpr size_t WS_FF = 7 * MiB;
constexpr size_t WS_KROPE = 8 * MiB;
constexpr size_t WS_SS = 10 * MiB;
constexpr size_t WS_W = 30 * MiB;
constexpr size_t W_IN = WS_W, W_UQ = W_IN + (size_t)NIN * DM * 2, W_UKV = W_UQ + (size_t)768 * 256 * 2, W_OUT = W_UKV + (size_t)768 * 128 * 2,
                 W_UP = W_OUT + (size_t)DM * DM * 2, W_DOWN = W_UP + (size_t)NUP * DM * 2, W_PG = W_DOWN + (size_t)DM * DFF * 2, W_PLE = W_PG + (size_t)DM * DM * 2, W_END = W_PLE + (size_t)DM * PLE * 2;
static_assert(W_END <= 58 * MiB, "weights region");
constexpr size_t WS_HBX = 58 * MiB;
constexpr size_t WS_PB = 122 * MiB;
constexpr size_t WS_R = 138 * MiB;
constexpr size_t WS_Z = WS_R, WS_Q = WS_R + 160 * MiB, WS_KV = WS_R + 196 * MiB, WS_OM = WS_R + 244 * MiB, WS_OF = WS_R + 268 * MiB, WS_MIX = WS_R + 292 * MiB;
constexpr size_t WS_ACT = WS_R + 176 * MiB, WS_T = WS_R;
constexpr size_t WS_END = 512 * MiB;
static_assert(WS_MIX + 64 * MiB <= WS_END && WS_ACT + 176 * MiB <= WS_END, "ws map");
constexpr int LDS_BYTES = 163840;
constexpr int RING_BYTES = 131072, XL_OFF = RING_BYTES + 1024;

#define RLX_AGENT __ATOMIC_RELAXED, __HIP_MEMORY_SCOPE_AGENT
#define XB_TMO      128
#define XB_XCNT(j)  (256  + 64 * (j))
#define XB_XSUB(j)  (1280 + 64 * (j))
#define XB_XGEN(j)  (2304 + 64 * (j))
#define XB_TOP      3328
#define XB_TOPGEN   3392
#define XCD_BAR_WORDS 3456
#define XB_SPIN_CAP (1u << 18)

__device__ __forceinline__ unsigned xb_ld(unsigned* p)              { return __hip_atomic_load(p, __ATOMIC_RELAXED, __HIP_MEMORY_SCOPE_AGENT); }
__device__ __forceinline__ unsigned xb_add(unsigned* p, unsigned v) { return __hip_atomic_fetch_add(p, v, __ATOMIC_RELAXED, __HIP_MEMORY_SCOPE_AGENT); }
__device__ __forceinline__ unsigned xb_xcc_id() { return (unsigned)__builtin_amdgcn_s_getreg((3 << 11) | 20) & 0xFu; }
#define XB_SPIN(cond, bar) do { unsigned _sp = 0; while (cond) { __builtin_amdgcn_s_sleep(1); \
    if ((++_sp & 255u) == 0u) { if (xb_ld(&(bar)[XB_TMO])) break; if (_sp > XB_SPIN_CAP) { atomicAdd(&(bar)[XB_TMO], 1u); break; } } } } while (0)

struct XcdBarrier {
    unsigned* bar; unsigned x;
    volatile LAS unsigned* st;
};

__device__ __forceinline__ XcdBarrier xcd_barrier_post(unsigned* bar, volatile LAS unsigned* st) {
    XcdBarrier b; b.bar = bar; b.x = xb_xcc_id(); b.st = st;
    if (threadIdx.x == 0) (void)xb_add(&bar[XB_XCNT(b.x)], 1u);
    return b;
}
__device__ __forceinline__ void xcd_barrier_complete(unsigned* bar, unsigned x, unsigned& nloc, unsigned& nx) {
    const unsigned G = gridDim.x * gridDim.y * gridDim.z;
    unsigned sum, cnt, mine, sp = 0u;
    for (;;) {
        sum = 0u; cnt = 0u; mine = 0u;
#pragma unroll
        for (unsigned j = 0; j < 16; ++j) { const unsigned c = xb_ld(&bar[XB_XCNT(j)]); sum += c; cnt += (c > 0u) ? 1u : 0u; mine = (j == x) ? c : mine; }
        if (sum == G) break;
        __builtin_amdgcn_s_sleep(1);
        if ((++sp & 255u) == 0u) { if (xb_ld(&bar[XB_TMO])) break; if (sp > XB_SPIN_CAP) { atomicAdd(&bar[XB_TMO], 1u); break; } }
    }
    nloc = mine > 0u ? mine : 1u; nx = cnt > 0u ? cnt : 1u;
}

__device__ __forceinline__ void xcd_barrier(const XcdBarrier& b) {
    asm volatile("s_waitcnt vmcnt(0)" ::: "memory");
    __syncthreads();
    if (threadIdx.x == 0) {
        unsigned* bar = b.bar;
        __builtin_amdgcn_s_waitcnt(0);
        unsigned nloc = b.st[0], nx = b.st[1];
        if (nloc == 0u) { xcd_barrier_complete(bar, b.x, nloc, nx); b.st[0] = nloc; b.st[1] = nx; }
        const unsigned old = xb_add(&bar[XB_XSUB(b.x)], 1u);
        const unsigned gen = old / nloc;
        if (old + 1u == (gen + 1u) * nloc) {
            __builtin_amdgcn_fence(__ATOMIC_RELEASE, "agent");
            asm volatile("s_waitcnt vmcnt(0)" ::: "memory");
            const unsigned og = xb_add(&bar[XB_TOP], 1u);
            const unsigned tg = og / nx;
            if (og + 1u == (tg + 1u) * nx) xb_add(&bar[XB_TOPGEN], 1u);
            else XB_SPIN(xb_ld(&bar[XB_TOPGEN]) == tg, bar);
            __builtin_amdgcn_fence(__ATOMIC_ACQUIRE, "agent");
            xb_add(&bar[XB_XGEN(b.x)], 1u);
            asm volatile("s_waitcnt vmcnt(0)" ::: "memory");
        } else {
            XB_SPIN(xb_ld(&bar[XB_XGEN(b.x)]) == gen, bar);
            __builtin_amdgcn_fence(__ATOMIC_ACQUIRE, "agent");
            asm volatile("s_waitcnt vmcnt(0)" ::: "memory");
        }
    }
    __syncthreads();
}

struct Args {
    const float* in[24]; float* out; unsigned char* ws; float inv_freq[16];
};

struct MapId { int n; __device__ __forceinline__ int operator()(int d) const { return d < n ? d : -1; } };
struct MapIn { __device__ __forceinline__ int operator()(int d) const {
    if (d < 384) return d;
    if (d < 416) { const int j = (d - 384) >> 1, e = (d - 384) & 1; return 384 + 16 * e + j; }
    if (d < 422) return 2336 + (d - 416);
    if (d < 512) return -1;
    if (d < 1280) return 416 + (d - 512);
    if (d < 2432) return 1184 + (d - 1280);
    return -1; } };
struct MapUq { __device__ __forceinline__ int operator()(int d) const {
    if (d >= QW) return -1; const int hd = d / 96, w = d % 96; if (w < 64) return d; const int j = (w - 64) >> 1, e = (w - 64) & 1; return 96 * hd + 64 + 16 * e + j; } };
struct MapUp { __device__ __forceinline__ int operator()(int d) const { const int tile = d >> 8, w = d & 255; return w < 128 ? 128 * tile + w : DFF + 128 * tile + (w - 128); } };
struct GainNone { __device__ __forceinline__ float operator()(int) const { return 1.f; } };
struct GainVec { const float* g; __device__ __forceinline__ float operator()(int k) const { return g[k]; } };
struct GainMix { const float *a, *b, *c; __device__ __forceinline__ float operator()(int k) const { return k < 384 ? a[k] : (k < 640 ? b[k - 384] : c[k - 640]); } };

template <class Map, class Gain>
__device__ __forceinline__ void transpose_item(const float* __restrict__ W, int K, int Nsrc, bf16_t* __restrict__ WT, int nblk, LAS float* scr, int item, int lane, Map map, Gain gain) {
    const int kb = item / nblk, nb = item % nblk, k0 = 64 * kb, n0 = 32 * nb;
    const int src = map(n0 + (lane & 31));
    float wv[32];
#pragma unroll
    for (int i = 0; i < 32; ++i) { const int kk = 2 * i + (lane >> 5); wv[i] = src >= 0 ? W[(size_t)(k0 + kk) * Nsrc + src] : 0.f; }
#pragma unroll
    for (int i = 0; i < 32; ++i) { const int kk = 2 * i + (lane >> 5); scr[kk * 33 + (lane & 31)] = wv[i] * gain(k0 + kk); }
    asm volatile("s_waitcnt lgkmcnt(0)" ::: "memory");
    const int c = lane & 7;
#pragma unroll
    for (int j = 0; j < 4; ++j) { const int n = (lane >> 3) + 8 * j; const LAS float* s = scr + (8 * c) * 33 + n;
        u32x4 o; o.x = pk2(s[0 * 33], s[1 * 33]); o.y = pk2(s[2 * 33], s[3 * 33]); o.z = pk2(s[4 * 33], s[5 * 33]); o.w = pk2(s[6 * 33], s[7 * 33]);
        *(u32x4*)(WT + (size_t)(n0 + n) * K + k0 + 8 * c) = o; }
    asm volatile("s_waitcnt lgkmcnt(0)" ::: "memory");
}

__global__ void __launch_bounds__(NTHREADS, 2) hymba_fwd(Args args) {
    extern __shared__ __attribute__((aligned(16))) unsigned char lds_raw[];
    LAS unsigned char* lds = (LAS unsigned char*)lds_raw;
    cg::grid_group grid = cg::this_grid();
    const int G = gridDim.x, bid = blockIdx.x;
    { volatile LAS unsigned* misc = (volatile LAS unsigned*)(lds + RING_BYTES); if (threadIdx.x < 16) misc[threadIdx.x] = 0u; __syncthreads(); }
    (void)xcd_barrier_post((unsigned*)(args.ws + WS_CTL) + 4096, (volatile LAS unsigned*)(lds + RING_BYTES) + 8);
#define GSYNC() do { XcdBarrier xb_; unsigned char* w_ = args.ws; asm volatile("" : "+s"(w_)); xb_.bar = (unsigned*)(w_ + WS_CTL) + 4096; xb_.x = xb_xcc_id(); xb_.st = (volatile LAS unsigned*)(lds + RING_BYTES) + 8; xcd_barrier(xb_); } while (0)
#define NGW (G * NWAVES)
#define NGT (G * NTHREADS)
#define PH_IDS int tid_o = threadIdx.x; asm volatile("" : "+v"(tid_o)); const int tid = tid_o, lane = tid & 63, wave = __builtin_amdgcn_readfirstlane(tid >> 6); \
    const int gw = bid * NWAVES + wave, gtid = bid * NTHREADS + tid; (void)gw; (void)gtid; (void)lane; \
    unsigned char* ws = args.ws; asm volatile("" : "+s"(ws));
#define ws_ ws
#define P_x ((const float*)args.in[0])
#define P_p_in ((const float*)args.in[1])
#define P_positions ((const int*)args.in[2])
#define P_out (args.out)
#define P_ctl ((unsigned*)(ws + WS_CTL))
#define P_ssb ((float*)(ws + WS_SS))
#define P_cs ((float*)(ws + WS_CS))
#define P_cum ((float*)(ws + WS_CUM))
#define P_ffbuf ((float*)(ws + WS_FF))
#define P_krope ((bf16_t*)(ws + WS_KROPE))
#define P_Win ((bf16_t*)(wb + (W_IN - WS_W)))
#define P_Wuq ((bf16_t*)(wb + (W_UQ - WS_W)))
#define P_Wukv ((bf16_t*)(wb + (W_UKV - WS_W)))
#define P_Wout ((bf16_t*)(wb + (W_OUT - WS_W)))
#define P_Wup ((bf16_t*)(wb + (W_UP - WS_W)))
#define P_Wdown ((bf16_t*)(wb + (W_DOWN - WS_W)))
#define P_Wpg ((bf16_t*)(wb + (W_PG - WS_W)))
#define P_Wple ((bf16_t*)(wb + (W_PLE - WS_W)))
#define P_hbX ((bf16_t*)(ws + WS_HBX))
#define P_hbY ((bf16_t*)args.out)
#define P_hbZ ((bf16_t*)(ws + WS_ACT))
#define P_pb ((bf16_t*)pbb)
#define P_zb ((bf16_t*)(ws + WS_Z))
#define P_qb_ ((bf16_t*)(ws + WS_Q))
#define P_kvb ((bf16_t*)(ws + WS_KV))
#define P_omla ((bf16_t*)(ws + WS_OM))
#define P_ofox ((bf16_t*)(ws + WS_OF))
#define P_mixed ((bf16_t*)(ws + WS_MIX))
#define P_act ((bf16_t*)(ws + WS_ACT))
#define P_tb ((bf16_t*)(ws + WS_T))
#define P_ss_attn (P_ssb + (size_t)(L * 5 + 0) * MROWS * 16)
#define P_ss_q (P_ssb + (size_t)(L * 5 + 1) * MROWS * 16)
#define P_ss_kv (P_ssb + (size_t)(L * 5 + 2) * MROWS * 16)
#define P_ss_ffn (P_ssb + (size_t)(L * 5 + 3) * MROWS * 16)
#define P_ss_ple (P_ssb + (size_t)(L * 5 + 4) * MROWS * 16)
#define P_ss_next (P_ssb + (size_t)((L + 1) % DEPTH * 5 + 0) * MROWS * 16)

#define LAYER_WB(l) ((l) == 0 ? ws + WS_W : (unsigned char*)args.out + (64u << 20))
#define LAYER_PB(l) ((l) == 0 ? ws + WS_PB : (unsigned char*)args.out + (92u << 20))
#define PH_IDS_L PH_IDS unsigned char* wb = LAYER_WB(L); unsigned char* pbb = LAYER_PB(L); (void)wb; (void)pbb;
    for (int L = 0; L < DEPTH; ++L) {
        for (int rep = 0; rep < 1 + ((REP_MASK >> 0) & 1); ++rep) { if (rep) GSYNC();
        if ((PHASE_MASK & (1 << 0)) && L == 0) { PH_IDS_L
            LAS float* scr = (LAS float*)(lds + wave * 16384);
            for (int Lw = 0; Lw < DEPTH; ++Lw) { unsigned char* wb = LAYER_WB(Lw); unsigned char* pbb = LAYER_PB(Lw);
            const float* attn_norm = args.in[3] + (size_t)Lw * DM; const float* w_in = args.in[4] + (size_t)Lw * DM * NIN_SRC;
            const float* q_norm = args.in[6] + (size_t)Lw * 256; const float* w_uq = args.in[7] + (size_t)Lw * 256 * QW;
            const float* kv_norm = args.in[8] + (size_t)Lw * 128; const float* w_ukv = args.in[9] + (size_t)Lw * 128 * KVW;
            const float* mla_on = args.in[11] + (size_t)Lw * 384; const float* conv_on = args.in[12] + (size_t)Lw * 256; const float* fox_on = args.in[13] + (size_t)Lw * 384;
            const float* w_out = args.in[14] + (size_t)Lw * DM * DM; const float* ffn_norm = args.in[15] + (size_t)Lw * DM; const float* w_up = args.in[16] + (size_t)Lw * DM * NUP;
            const float* w_down = args.in[19] + (size_t)Lw * DFF * DM; const float* ple_norm = args.in[20] + (size_t)Lw * DM; const float* w_pg = args.in[21] + (size_t)Lw * DM * DM;
            const float* w_ple = args.in[22] + (size_t)Lw * PLE * DM;
            constexpr int I_IN = (DM / 64) * (NIN / 32), I_UQ = (256 / 64) * (768 / 32), I_UKV = (128 / 64) * (768 / 32), I_OUT = (DM / 64) * (DM / 32), I_UP = (DM / 64) * (NUP / 32),
                          I_DOWN = (DFF / 64) * (DM / 32), I_PG = I_OUT, I_PLE = (PLE / 64) * (DM / 32);
            constexpr int NITEMS = I_IN + I_UQ + I_UKV + I_OUT + I_UP + I_DOWN + I_PG + I_PLE;
            for (int it = gw; it < NITEMS; it += NGW) {
                int r = it;
                if (r < I_UP) { transpose_item(w_up, DM, NUP, P_Wup, NUP / 32, scr, r, lane, MapUp{}, GainVec{ffn_norm}); continue; } r -= I_UP;
                if (r < I_DOWN) { transpose_item(w_down, DFF, DM, P_Wdown, DM / 32, scr, r, lane, MapId{DM}, GainNone{}); continue; } r -= I_DOWN;
                if (r < I_IN) { transpose_item(w_in, DM, NIN_SRC, P_Win, NIN / 32, scr, r, lane, MapIn{}, GainVec{attn_norm}); continue; } r -= I_IN;
                if (r < I_OUT) { transpose_item(w_out, DM, DM, P_Wout, DM / 32, scr, r, lane, MapId{DM}, GainMix{mla_on, conv_on, fox_on}); continue; } r -= I_OUT;
                if (r < I_PG) { transpose_item(w_pg, DM, DM, P_Wpg, DM / 32, scr, r, lane, MapId{DM}, GainVec{ple_norm}); continue; } r -= I_PG;
                if (r < I_UQ) { transpose_item(w_uq, 256, QW, P_Wuq, 768 / 32, scr, r, lane, MapUq{}, GainVec{q_norm}); continue; } r -= I_UQ;
                if (r < I_UKV) { transpose_item(w_ukv, 128, KVW, P_Wukv, 768 / 32, scr, r, lane, MapId{KVW}, GainVec{kv_norm}); continue; } r -= I_UKV;
                transpose_item(w_ple, PLE, DM, P_Wple, DM / 32, scr, r, lane, MapId{DM}, GainNone{});
            }
            if (Lw == 0)
            { const float* pl = P_p_in + (size_t)Lw * MROWS * PLE;
              for (size_t i = gtid; i < (size_t)MROWS * PLE / 8; i += NGT) { const f32x4 a = *(const f32x4*)(pl + i * 8), b = *(const f32x4*)(pl + i * 8 + 4); *(u32x4*)(P_pb + i * 8) = pg8::pack8(a, b); } }
            }
            if (L == 0) {
                { constexpr int RB = 4; const void* x_ = P_x; void* hy_ = P_hbY; float* ssa_ = P_ss_attn;
                  for (int m0 = gw; m0 < MROWS; m0 += RB * NGW) { float sm[RB]; f32x4 v[RB][4];
#pragma unroll
                    for (int k = 0; k < RB; ++k) { const unsigned m = (unsigned)min(m0 + k * NGW, MROWS - 1); sm[k] = 0.f;
#pragma unroll
                        for (int jj = 0; jj < 4; ++jj) { v[k][jj] = gld<f32x4>(x_, m * 4096u + (lane + 64 * jj) * 16); sm[k] += (v[k][jj].x * v[k][jj].x + v[k][jj].y * v[k][jj].y) + (v[k][jj].z * v[k][jj].z + v[k][jj].w * v[k][jj].w); } }
#pragma unroll
                    for (int o = 1; o < 64; o <<= 1) {
#pragma unroll
                        for (int k = 0; k < RB; ++k) sm[k] += __shfl_xor(sm[k], o); }
#pragma unroll
                    for (int k = 0; k < RB; ++k) { const unsigned m = (unsigned)min(m0 + k * NGW, MROWS - 1);
#pragma unroll
                        for (int jj = 0; jj < 4; ++jj) gst<u32x2>(hy_, m * 2048u + (lane + 64 * jj) * 8, (u32x2){pk2(v[k][jj].x, v[k][jj].y), pk2(v[k][jj].z, v[k][jj].w)});
                        if (lane == 0) ssa_[(size_t)m * 16] = sm[k]; } } }
                for (int i = gtid; i < MROWS * 16; i += NGT) {
                    const int m = i >> 4, j = i & 15; const float ang = (float)P_positions[m] * args.inv_freq[j];
                    const double rev = (double)ang * 0.15915494309189535; const float fr = (float)(rev - rint(rev));
                    P_cs[2 * i] = __builtin_amdgcn_cosf(fr); P_cs[2 * i + 1] = __builtin_amdgcn_sinf(fr);
                }
            }
        } }
        if (L == 0) { if (args.out == nullptr) grid.sync(); GSYNC(); }
        for (int rep = 0; rep < 1 + ((REP_MASK >> 1) & 1); ++rep) { if (rep) GSYNC();
        if (PHASE_MASK & (1 << 1)) { PH_IDS_L
            pg8::Gemm g{P_hbY, P_Win, MROWS, NIN, DM, DM, DM, 256, 0}; pg8::StaticOrder S; S.init(MROWS, NIN, G, bid);
            pg8::EpiZ E{P_zb, P_ss_attn, L == 0 ? 1 : 16, P_ss_q, P_ss_kv, P_ffbuf, P_krope, P_cs, P_ctl + 128 + 64 * L};
            pg8::gemm_phase<pg8::EpiZ, pg8::StaticOrder, true>(lds, lds + XL_OFF, g, S, E);
        } }
        GSYNC();
        for (int rep = 0; rep < 1 + ((REP_MASK >> 2) & 1); ++rep) { if (rep) GSYNC();
        if (PHASE_MASK & (1 << 2)) { PH_IDS_L
            { pg8::Gemm g{P_zb, P_Wuq, MROWS, 768, 256, NIN, 256, 256, 0}; pg8::StaticOrder S; S.init(MROWS, 768, G, bid);
              pg8::EpiQ E{P_qb_, P_ss_q, P_cs}; pg8::gemm_phase<pg8::EpiQ, pg8::StaticOrder, true>(lds, lds + XL_OFF, g, S, E); }
            { pg8::Gemm g{P_zb + 256, P_Wukv, MROWS, 768, 128, NIN, 128, 256, 0}; pg8::StaticOrder S; S.init(MROWS, 768, G, (bid + G / 2) % G);
              pg8::EpiRowScale E{P_kvb, KVW, P_ss_kv, 4, 1.f / 128.f, 1.f}; pg8::gemm_phase<pg8::EpiRowScale, pg8::StaticOrder, true>(lds, lds + XL_OFF, g, S, E); }
            const float* bfg = args.in[5] + (size_t)L * 6;
            for (int bh = (bid + G - G / 2) % G; bh < 48; bh += G) {
                const int b = bh / 6, hd = bh % 6; const float bf = bfg[hd]; const int s0 = tid * 8;
                float v[8]; float run = 0.f;
#pragma unroll
                for (int e = 0; e < 8; ++e) { const float xv = P_ffbuf[((size_t)b * SEQ + s0 + e) * 8 + hd] + bf; const float ls = fminf(xv, 0.f) - __logf(1.f + __expf(-fabsf(xv))); run += ls * LOG2E; v[e] = run; }
                float tot = run;
#pragma unroll
                for (int o = 1; o < 64; o <<= 1) { const float tt = __shfl_up(tot, o); if (lane >= o) tot += tt; }
                LAS float* wsum = (LAS float*)lds;
                __syncthreads();
                if (lane == 63) wsum[wave] = tot;
                __syncthreads();
                float off = tot - run;
                for (int w = 0; w < wave; ++w) off += wsum[w];
#pragma unroll
                for (int e = 0; e < 8; ++e) P_cum[(size_t)bh * SEQ + s0 + e] = off + v[e];
                __syncthreads();
            }
        } }
        GSYNC();
        for (int rep = 0; rep < 1 + ((REP_MASK >> 3) & 1); ++rep) { if (rep) GSYNC();
          if (PHASE_MASK & (1 << 3)) { PH_IDS_L
            LAS int* ubox = (LAS int*)(lds + att::OFF_U);
            const int home = (int)(xb_xcc_id() & 7u);
            int qi = 0, xq = home, u;
#define ATT_POP_SYNC() do { if (tid == 0) ubox[0] = (int)atomicAdd(P_ctl + 64 * L + 16 * rep + xq, 1u); __syncthreads(); u = ubox[0]; __syncthreads(); } while (0)
            ATT_POP_SYNC();
            for (;;) {
                while (u >= 192 && ++qi < 8) { xq = (home + qi) & 7; ATT_POP_SYNC(); }
                if (u >= 192) break;
                unsigned pnext = 0u; if (tid == 0) pnext = atomicAdd(P_ctl + 64 * L + 16 * rep + xq, 1u);
                {
                    const int type = u >= 96, ui = type ? u - 96 : u, qb = 15 - ui / 6, bh = xq * 6 + ui % 6, b = bh / 6, hd = bh % 6;
                    if (type == 0) att::attn_unit<true>((LAS char*)lds, b, hd, qb, P_qb_, QW, hd * 96, P_kvb, KVW, hd * 128, P_krope, P_kvb, KVW, hd * 128 + 64, P_cum, P_omla, 384, hd * 64, 0);
                    else {
                        const unsigned* nbw = P_ctl + 128 + 64 * L + bh;
                        const float Bq = 1.01f * sqrtf((__uint_as_float(nbw[0]) + __uint_as_float(nbw[256])) * (__uint_as_float(nbw[128]) + __uint_as_float(nbw[384])));
                        const float thr = -(64.f + 2.f * Bq); const float* cu = P_cum + (size_t)bh * SEQ; const float cq = cu[qb * 256];
                        const int it_ = lane & 31; const bool sk = it_ < 2 * qb && (cq - cu[128 * (it_ < 2 * qb ? it_ : 0) + 127] < thr);
                        const int lo = __popcll(__ballot(sk) & 0xffffffffull);
                        att::attn_unit<false>((LAS char*)lds, b, hd, qb, P_zb, NIN, ZC_FQ + hd * 64, P_zb, NIN, ZC_FK + hd * 64, P_krope, P_zb, NIN, ZC_FV + hd * 64, P_cum, P_ofox, 384, hd * 64, lo);
                    }
                }
                if (tid == 0) ubox[0] = (int)pnext;
                __syncthreads(); u = ubox[0]; __syncthreads();
            }
#undef ATT_POP_SYNC
          }
        }
        GSYNC();
        for (int rep = 0; rep < 1 + ((REP_MASK >> 4) & 1); ++rep) { if (rep) GSYNC();
        if (PHASE_MASK & (1 << 4)) { PH_IDS_L
            const float* cw = args.in[10] + (size_t)L * 3 * 256;
            const f32x4 w0 = *(const f32x4*)(cw + 4 * lane), w1 = *(const f32x4*)(cw + 256 + 4 * lane), w2 = *(const f32x4*)(cw + 512 + 4 * lane);
            constexpr int RB = 4;
            const void *om_ = P_omla, *of_ = P_ofox, *zb_ = P_zb; void* mx_ = P_mixed;
            for (int row0 = gw; row0 < MROWS; row0 += RB * NGW) {
                float am[RB][6], af[RB][6], sa[RB], sf[RB], sc[RB]; f32x4 oc[RB];
#pragma unroll
                for (int k = 0; k < RB; ++k) { const unsigned row = (unsigned)min(row0 + k * NGW, MROWS - 1); const int tpos = row & (SEQ - 1);
                    sa[k] = 0.f; sf[k] = 0.f;
#pragma unroll
                    for (int j = 0; j < 3; ++j) { const unsigned ua = gld<unsigned>(om_, (row * 384 + j * 128 + 2 * lane) * 2), uf = gld<unsigned>(of_, (row * 384 + j * 128 + 2 * lane) * 2);
                        am[k][2 * j] = bflo(ua); am[k][2 * j + 1] = bfhi(ua); af[k][2 * j] = bflo(uf); af[k][2 * j + 1] = bfhi(uf);
                        sa[k] += am[k][2 * j] * am[k][2 * j] + am[k][2 * j + 1] * am[k][2 * j + 1]; sf[k] += af[k][2 * j] * af[k][2 * j] + af[k][2 * j + 1] * af[k][2 * j + 1]; }
                    const unsigned zo = (row * NIN + 4 * lane) * 2;
                    const u32x2 b0 = gld<u32x2>(zb_, zo + ZC_ZB * 2), c0 = gld<u32x2>(zb_, zo + ZC_ZC * 2), h0 = gld<u32x2>(zb_, zo + ZC_ZH * 2);
                    u32x2 c1 = {0u, 0u}, h1 = {0u, 0u}, c2 = {0u, 0u}, h2 = {0u, 0u};
                    if (tpos >= 1) { c1 = gld<u32x2>(zb_, zo - NIN * 2 + ZC_ZC * 2); h1 = gld<u32x2>(zb_, zo - NIN * 2 + ZC_ZH * 2); }
                    if (tpos >= 2) { c2 = gld<u32x2>(zb_, zo - NIN * 4 + ZC_ZC * 2); h2 = gld<u32x2>(zb_, zo - NIN * 4 + ZC_ZH * 2); }
                    oc[k][0] = bflo(b0.x) * (w0[0] * bflo(c2.x) * bflo(h2.x) + w1[0] * bflo(c1.x) * bflo(h1.x) + w2[0] * bflo(c0.x) * bflo(h0.x));
                    oc[k][1] = bfhi(b0.x) * (w0[1] * bfhi(c2.x) * bfhi(h2.x) + w1[1] * bfhi(c1.x) * bfhi(h1.x) + w2[1] * bfhi(c0.x) * bfhi(h0.x));
                    oc[k][2] = bflo(b0.y) * (w0[2] * bflo(c2.y) * bflo(h2.y) + w1[2] * bflo(c1.y) * bflo(h1.y) + w2[2] * bflo(c0.y) * bflo(h0.y));
                    oc[k][3] = bfhi(b0.y) * (w0[3] * bfhi(c2.y) * bfhi(h2.y) + w1[3] * bfhi(c1.y) * bfhi(h1.y) + w2[3] * bfhi(c0.y) * bfhi(h0.y));
                    sc[k] = (oc[k][0] * oc[k][0] + oc[k][1] * oc[k][1]) + (oc[k][2] * oc[k][2] + oc[k][3] * oc[k][3]); }
#pragma unroll
                for (int o = 1; o < 64; o <<= 1) {
#pragma unroll
                    for (int k = 0; k < RB; ++k) { sa[k] += __shfl_xor(sa[k], o); sf[k] += __shfl_xor(sf[k], o); sc[k] += __shfl_xor(sc[k], o); } }
#pragma unroll
                for (int k = 0; k < RB; ++k) { const unsigned row = (unsigned)min(row0 + k * NGW, MROWS - 1);
                    const float ra = __builtin_amdgcn_rsqf(sa[k] * (1.f / 384.f) + EPS), rf = __builtin_amdgcn_rsqf(sf[k] * (1.f / 384.f) + EPS), rc = __builtin_amdgcn_rsqf(sc[k] * (1.f / 256.f) + EPS);
                    const unsigned mo = row * DM * 2;
#pragma unroll
                    for (int j = 0; j < 3; ++j) { gst<unsigned>(mx_, mo + (j * 128 + 2 * lane) * 2, pk2(am[k][2 * j] * ra, am[k][2 * j + 1] * ra)); gst<unsigned>(mx_, mo + (640 + j * 128 + 2 * lane) * 2, pk2(af[k][2 * j] * rf, af[k][2 * j + 1] * rf)); }
                    gst<u32x2>(mx_, mo + (384 + 4 * lane) * 2, (u32x2){pk2(oc[k][0] * rc, oc[k][1] * rc), pk2(oc[k][2] * rc, oc[k][3] * rc)}); }
            }
        } }
        GSYNC();
        for (int rep = 0; rep < 1 + ((REP_MASK >> 5) & 1); ++rep) { if (rep) GSYNC();
        if (PHASE_MASK & (1 << 5)) { PH_IDS_L
            pg8::Gemm g{P_mixed, P_Wout, MROWS, DM, DM, DM, DM, 256, 0}; pg8::StaticOrder S; S.init(MROWS, DM, G, bid);
            pg8::EpiRes E{P_hbY, P_hbX, P_ss_ffn}; pg8::gemm_phase<pg8::EpiRes, pg8::StaticOrder, true>(lds, lds + XL_OFF, g, S, E);
        } }
        GSYNC();
        for (int rep = 0; rep < 1 + ((REP_MASK >> 6) & 1); ++rep) { if (rep) GSYNC();
          if (PHASE_MASK & (1 << 6)) { PH_IDS_L
            const float* fcw = args.in[17] + (size_t)L * 3 * NUP; const float* fcb = args.in[18] + (size_t)L * NUP;
            pg8::Gemm g{P_hbX, P_Wup, 130 * 256, NUP, DM, DM, DM, 254, -2}; pg8::StaticOrder S; S.init(130 * 256, NUP, G, bid);
            pg8::EpiFfn E{P_act, P_ss_ffn, fcw, fcb}; pg8::gemm_phase<pg8::EpiFfn, pg8::StaticOrder, true>(lds, lds + XL_OFF, g, S, E);
            { const int rem = (130 * (NUP / 256)) % G, c7 = rem ? bid - rem : bid, g7 = rem ? G - rem : G;
              if (c7 >= 0) { pg8::Gemm g2{P_pb, P_Wple, MROWS, DM, PLE, PLE, PLE, 256, 0}; pg8::StaticOrder S2; S2.init(MROWS, DM, g7, c7);
                pg8::EpiRowScale E2{P_tb, DM, nullptr, 0, 0.f, 1.f}; pg8::gemm_phase<pg8::EpiRowScale, pg8::StaticOrder, true>(lds, lds + XL_OFF, g2, S2, E2);
                if (L + 1 < DEPTH) { const void* pl_ = P_p_in + (size_t)(L + 1) * MROWS * PLE; void* pd_ = LAYER_PB(L + 1); constexpr unsigned NIT = (unsigned)MROWS * PLE / 8;
                    for (unsigned i = (unsigned)c7 * NTHREADS + tid; i < NIT; i += (unsigned)g7 * NTHREADS) { const f32x4 a = gld<f32x4>(pl_, i * 32u), b = gld<f32x4>(pl_, i * 32u + 16u); gst<u32x4>(pd_, i * 16u, pg8::pack8(a, b)); } } } }
          }
        }
        GSYNC();
        if (PHASE_MASK & (1 << 7)) { PH_IDS_L
#ifndef NO_G6
            { pg8::Gemm g{P_act, P_Wdown, MROWS, DM, DFF, DFF, DFF, 256, 0}; pg8::StaticOrder S; S.init(MROWS, DM, G, bid);
              pg8::EpiRes E{P_hbX, P_hbX, P_ss_ple}; pg8::gemm_phase<pg8::EpiRes, pg8::StaticOrder, true>(lds, lds + XL_OFF, g, S, E); }
#endif
        }
        GSYNC();
        for (int rep = 0; rep < 1 + ((REP_MASK >> 8) & 1); ++rep) { if (rep) GSYNC();
        if (PHASE_MASK & (1 << 8)) { PH_IDS_L
            pg8::Gemm g{P_hbX, P_Wpg, MROWS, DM, DM, DM, DM, 256, 0}; pg8::StaticOrder S; S.init(MROWS, DM, G, bid);
            pg8::EpiGate E{P_hbX, L == DEPTH - 1 ? P_hbZ : P_hbY, P_ss_next, P_ss_ple, P_tb}; pg8::gemm_phase<pg8::EpiGate, pg8::StaticOrder, true>(lds, lds + XL_OFF, g, S, E);
        } }
        GSYNC();
    }
    { PH_IDS
        const float* fg = args.in[23];
        { constexpr int RB = 4; const void* hz_ = P_hbZ; void* o_ = P_out;
          f32x4 gg[4];
#pragma unroll
          for (int j = 0; j < 2; ++j) { gg[2 * j] = *((const f32x4*)fg + 2 * lane + 128 * j); gg[2 * j + 1] = *((const f32x4*)fg + 2 * lane + 128 * j + 1); }
          for (int m0 = gw; m0 < MROWS; m0 += RB * NGW) { f32x4 v[RB][4]; float sm[RB];
#pragma unroll
            for (int k = 0; k < RB; ++k) { const unsigned m = (unsigned)min(m0 + k * NGW, MROWS - 1); sm[k] = 0.f;
#pragma unroll
                for (int j = 0; j < 2; ++j) { pg8::unpack8(gld<u32x4>(hz_, m * 2048u + (lane + 64 * j) * 16), v[k][2 * j], v[k][2 * j + 1]); sm[k] += pg8::dot8(v[k][2 * j], v[k][2 * j + 1]); } }
#pragma unroll
            for (int o = 1; o < 64; o <<= 1) {
#pragma unroll
                for (int k = 0; k < RB; ++k) sm[k] += __shfl_xor(sm[k], o); }
#pragma unroll
            for (int k = 0; k < RB; ++k) { const unsigned m = (unsigned)min(m0 + k * NGW, MROWS - 1); const float rs = __builtin_amdgcn_rsqf(sm[k] * (1.f / DM) + EPS);
#pragma unroll
                for (int j = 0; j < 2; ++j) { gst<f32x4>(o_, m * 4096u + (2 * lane + 128 * j) * 16, v[k][2 * j] * rs * gg[2 * j]); gst<f32x4>(o_, m * 4096u + (2 * lane + 128 * j + 1) * 16, v[k][2 * j + 1] * rs * gg[2 * j + 1]); } }
          } }
    }
}

extern "C" void kernel_launch(void* const* d_in, const int* in_sizes, int n_in, void* d_out, int out_size, void* d_ws, size_t ws_size, hipStream_t stream) {
    static int grid = 0;
    if (grid == 0) {
        if (n_in != 24 || out_size != MROWS * DM || ws_size < WS_END) { fprintf(stderr, "kernel_launch: unexpected shapes: n_in %d out %d ws %zu (need %zu)\n", n_in, out_size, ws_size, (size_t)WS_END); grid = -1; return; }
        int dev = 0, cus = 0, per_cu = 0;
        if (hipGetDevice(&dev) != hipSuccess || hipDeviceGetAttribute(&cus, hipDeviceAttributeMultiprocessorCount, dev) != hipSuccess) { grid = -1; return; }
        if (hipFuncSetAttribute((const void*)hymba_fwd, hipFuncAttributeMaxDynamicSharedMemorySize, LDS_BYTES) != hipSuccess) { fprintf(stderr, "kernel_launch: hipFuncSetAttribute failed\n"); grid = -1; return; }
        if (hipOccupancyMaxActiveBlocksPerMultiprocessor(&per_cu, (const void*)hymba_fwd, NTHREADS, LDS_BYTES) != hipSuccess || per_cu < 1) { fprintf(stderr, "kernel_launch: occupancy query gives %d\n", per_cu); per_cu = 1; }
        (void)hipGetLastError();
        grid = cus * 1;
    }
    if (grid < 0) return;
    (void)hipMemsetAsync((char*)d_ws + WS_CTL, 0, ZERO_BYTES, stream);
    Args a{};
    for (int i = 0; i < 24; ++i) a.in[i] = (const float*)d_in[i];
    a.out = (float*)d_out; a.ws = (unsigned char*)d_ws;
    for (int j = 0; j < 16; ++j) a.inv_freq[j] = powf(10000.0f, -(float)(2 * j) / 32.0f);
    void* kargs[] = {&a};
    hipError_t e = hipLaunchCooperativeKernel((const void*)hymba_fwd, dim3(grid), dim3(NTHREADS), kargs, LDS_BYTES, stream);
    if (e != hipSuccess) fprintf(stderr, "kernel_launch: cooperative launch failed: %s (grid %d)\n", hipGetErrorString(e), grid);
}
```
